# Optimizing an MI355X kernel written in HIP

```python
import jax
import jax.numpy as jnp
from jax import lax
import numpy as np

D_MODEL = 1024
BATCH = 8
SEQ = 4096
DEPTH = 4

GRID_W = 64
CTX_LEN = 256
HEAD_DIM = 64
N_RWKV_HEADS = 8
D_RWKV = N_RWKV_HEADS * HEAD_DIM
D_POOL = D_MODEL - D_RWKV
POOL_WINDOWS = (2, 4, 8, 16)
POOL_GROUP = D_POOL // len(POOL_WINDOWS)
D_DECAY_LORA = 32
D_AAA_LORA = 64
D_GATE_LORA = 96
D_RWKV_PROJ = 3 * D_RWKV + 2 * D_DECAY_LORA + 2 * D_AAA_LORA + D_GATE_LORA
D_EVEN_IN = D_RWKV_PROJ + D_POOL
D_FF = 2816
RMS_EPS = 1e-6
GN_EPS = 64e-5

kernel_name = 'hybrid_rwkv7_pool_shortconv_dit_block'


def rmsnorm(x, g):
    xf = x.astype(jnp.float32)
    y = xf * lax.rsqrt(jnp.mean(xf * xf, axis=-1, keepdims=True) + RMS_EPS)
    return (y * g).astype(x.dtype)


def modulate(h, shift, scale):
    return h * (1.0 + scale) + shift


def neighbours(x, grid):
    n_rows, row_len = grid
    bsz, _, ch = x.shape
    xp = jnp.pad(x.reshape(bsz, n_rows, row_len, ch), ((0, 0), (0, 0), (1, 1), (0, 0)))
    return xp[:, :, :-2].reshape(x.shape), xp[:, :, 2:].reshape(x.shape)


def dwconv3(x, w, grid):
    prev, nxt = neighbours(x, grid)
    return prev * w[0] + x * w[1] + nxt * w[2]


def multiscale_pool(x, w_group, scale, grid):
    n_rows, row_len = grid
    bsz, _, ch = x.shape
    xr = x.reshape(bsz, n_rows, row_len, ch).astype(jnp.float32)
    cs = jnp.concatenate([jnp.zeros_like(xr[:, :, :1]), jnp.cumsum(xr, axis=2)], axis=2)
    pos = jnp.arange(row_len)
    outs = []
    for gi, win in enumerate(POOL_WINDOWS):
        sl = slice(gi * POOL_GROUP, (gi + 1) * POOL_GROUP)
        lo = jnp.clip(pos - win // 2, 0, row_len)
        hi = jnp.clip(pos + win // 2, 0, row_len)
        csg = cs[..., sl]
        mean = (jnp.take(csg, hi, axis=2) - jnp.take(csg, lo, axis=2)) / (hi - lo).astype(jnp.float32)[:, None]
        d = (mean - xr[..., sl]).astype(x.dtype)
        outs.append(jnp.einsum('brlc,cd->brld', d, w_group[gi]))
    return jnp.concatenate(outs, axis=-1).reshape(x.shape) * scale


def to_heads(t):
    return t.reshape(t.shape[:-1] + (N_RWKV_HEADS, HEAD_DIM))


def rwkv_inputs(pr, mu, w0, w_up, a0, a_up, g_up, k_k, k_a):
    bsz, seq, _ = pr.shape
    prev, nxt = neighbours(pr, (1, seq))
    pr = pr + mu[0] * (prev - pr) + mu[1] * (nxt - pr)
    o1, o2, o3 = D_RWKV, 2 * D_RWKV, 3 * D_RWKV
    o4 = o3 + 2 * D_DECAY_LORA
    o5 = o4 + 2 * D_AAA_LORA
    r, k, v = pr[..., :o1], pr[..., o1:o2], pr[..., o2:o3]
    lw = pr[..., o3:o4].reshape(bsz, seq, 2, D_DECAY_LORA)
    la = pr[..., o4:o5].reshape(bsz, seq, 2, D_AAA_LORA)
    lg = pr[..., o5:]
    w = w0 + jnp.einsum('bsdr,drc->bsdc', jnp.tanh(lw), w_up)
    w = -jax.nn.softplus(-w.astype(jnp.float32)) - 0.5
    decay = jnp.exp(-jnp.exp(w))
    a = jax.nn.sigmoid(a0 + jnp.einsum('bsdr,drc->bsdc', la, a_up))
    kk = to_heads((k * k_k).astype(jnp.float32))
    kk = kk * lax.rsqrt(jnp.maximum(jnp.sum(kk * kk, axis=-1, keepdims=True), 1e-24))
    kd = k[:, :, None, :] * (1.0 + (a - 1.0) * k_a)
    b = kk[:, :, None] * to_heads(a)
    g = jax.nn.sigmoid(lg) @ g_up
    return (to_heads(r), to_heads(v), kk, to_heads(decay), to_heads(kd), b, g)


def wkv_scan(state, r, v, kk, decay, kd, b, reverse):
    tm = lambda t: jnp.swapaxes(t.astype(jnp.float32), 0, 1)

    def step(S, inp):
        r_t, v_t, kk_t, w_t, k_t, b_t = inp
        sa = jnp.einsum('bhvk,bhk->bhv', S, kk_t)
        S = S * w_t[:, :, None, :] - sa[..., None] * b_t[:, :, None, :] + v_t[..., None] * k_t[:, :, None, :]
        return S, jnp.einsum('bhvk,bhk->bhv', S, r_t)

    state, ys = lax.scan(step, state, (tm(r), tm(v), tm(kk), tm(decay), tm(kd), tm(b)), reverse=reverse)
    return state, jnp.swapaxes(ys, 0, 1)


def rwkv_output(y, r, v, kd, r_k, gn_w, gn_b, g):
    bsz, seq = y.shape[:2]
    mean = jnp.mean(y, axis=-1, keepdims=True)
    yc = y - mean
    yn = yc * lax.rsqrt(jnp.mean(yc * yc, axis=-1, keepdims=True) + GN_EPS)
    yn = yn.reshape(bsz, seq, D_RWKV) * gn_w + gn_b
    coef = jnp.sum(r[:, :, None].astype(jnp.float32) * kd.astype(jnp.float32) * r_k, axis=(2, 4))
    bonus = (coef[..., None] * v).reshape(bsz, seq, D_RWKV)
    return ((yn + bonus) * g).astype(g.dtype)


def even_mixer(h, hc, lat_grid, ctx_grid, want_ctx, w_in, w_out, mu, w0, w_up, a0, a_up, g_up,
               k_k, k_a, r_k, gn_w, gn_b, pool_w, pool_scale):
    p = h @ w_in
    pc = hc @ w_in
    lat = rwkv_inputs(p[..., :D_RWKV_PROJ], mu, w0, w_up, a0, a_up, g_up, k_k, k_a)
    cx = rwkv_inputs(pc[..., :D_RWKV_PROJ], mu, w0, w_up, a0, a_up, g_up, k_k, k_a)
    zero = jnp.zeros((h.shape[0], N_RWKV_HEADS, HEAD_DIM, HEAD_DIM), jnp.float32)
    ys_l, ys_c = [], []
    for d in range(2):
        s_c, y_c = wkv_scan(zero, cx[0], cx[1], cx[2], cx[3][:, :, d], cx[4][:, :, d], cx[5][:, :, d], d == 1)
        _, y_l = wkv_scan(s_c, lat[0], lat[1], lat[2], lat[3][:, :, d], lat[4][:, :, d], lat[5][:, :, d], d == 1)
        ys_l.append(y_l)
        ys_c.append(y_c)

    def merge(inp, ys, pp, grid):
        r, v, _, _, kd, _, g = inp
        y_rwkv = rwkv_output(ys[0] + ys[1], r, v, kd, r_k, gn_w, gn_b, g)
        y_pool = multiscale_pool(pp[..., D_RWKV_PROJ:], pool_w, pool_scale, grid)
        return jnp.concatenate([y_rwkv, y_pool], axis=-1) @ w_out

    y = merge(lat, ys_l, p, lat_grid)
    y_ctx = merge(cx, ys_c, pc, ctx_grid) if want_ctx else None
    return y, y_ctx


def conv_mixer(h, w_in, conv_w, w_out, grid):
    p = h @ w_in
    bg, cg, u = jnp.split(p, 3, axis=-1)
    return (bg * dwconv3(cg * u, conv_w, grid)) @ w_out


def conv_ffn(h, w_up, conv_w, w_down, grid):
    p = h @ w_up
    return (jax.nn.silu(dwconv3(p[..., :D_FF], conv_w, grid)) * p[..., D_FF:]) @ w_down


def setup_inputs(seed: int = 0) -> dict:
    key = jax.random.key(seed)
    ks = iter(jax.random.split(key, 40))
    f32 = jnp.float32
    nrm = lambda shape, s: jax.random.normal(next(ks), shape, f32) * s
    uni = lambda shape, lo, hi: jax.random.uniform(next(ks), shape, f32, lo, hi)
    D = D_MODEL
    ne = (DEPTH + 1) // 2
    no = DEPTH // 2
    return {
        'x': nrm((BATCH, SEQ, D), 1.0),
        'c': nrm((BATCH, D), 1.0),
        'ctx': nrm((BATCH, CTX_LEN, D), 1.0),
        'c_ctx': nrm((D,), 1.0),
        'w_mod': nrm((DEPTH, D, 6 * D), D ** -0.5),
        'b_mod': nrm((DEPTH, 6 * D), 0.02),
        'norm_g': 1.0 + nrm((DEPTH, 4, D), 0.05),
        'ffn_w_up': nrm((DEPTH, D, 2 * D_FF), D ** -0.5),
        'ffn_conv': nrm((DEPTH, 3, D_FF), 3 ** -0.5),
        'ffn_w_down': nrm((DEPTH, D_FF, D), D_FF ** -0.5),
        'ev_w_in': nrm((ne, D, D_EVEN_IN), D ** -0.5),
        'ev_w_out': nrm((ne, D, D), D ** -0.5),
        'ev_mu': uni((ne, 2, D_RWKV_PROJ), 0.0, 0.5),
        'ev_w0': uni((ne, 2, D_RWKV), -4.0, 0.0),
        'ev_w_up': nrm((ne, 2, D_DECAY_LORA, D_RWKV), 0.5 * D_DECAY_LORA ** -0.5),
        'ev_a0': nrm((ne, 2, D_RWKV), 0.5),
        'ev_a_up': nrm((ne, 2, D_AAA_LORA, D_RWKV), D_AAA_LORA ** -0.5),
        'ev_g_up': nrm((ne, D_GATE_LORA, D_RWKV), D_GATE_LORA ** -0.5),
        'ev_k_k': 0.85 + nrm((ne, D_RWKV), 0.05),
        'ev_k_a': 1.0 + nrm((ne, D_RWKV), 0.05),
        'ev_r_k': nrm((ne, N_RWKV_HEADS, HEAD_DIM), 0.1),
        'ev_gn_w': 1.0 + nrm((ne, D_RWKV), 0.05),
        'ev_gn_b': nrm((ne, D_RWKV), 0.02),
        'ev_pool_w': nrm((ne, len(POOL_WINDOWS), POOL_GROUP, POOL_GROUP), POOL_GROUP ** -0.5),
        'ev_pool_scale': 1.0 + nrm((ne, D_POOL), 0.05),
        'od_w_in': nrm((no, D, 3 * D), D ** -0.5),
        'od_conv': nrm((no, 3, D), 3 ** -0.5),
        'od_w_out': nrm((no, D, D), D ** -0.5),
    }


def reference(x, c, ctx, c_ctx, w_mod, b_mod, norm_g, ffn_w_up, ffn_conv, ffn_w_down,
              ev_w_in, ev_w_out, ev_mu, ev_w0, ev_w_up, ev_a0, ev_a_up, ev_g_up, ev_k_k, ev_k_a,
              ev_r_k, ev_gn_w, ev_gn_b, ev_pool_w, ev_pool_scale, od_w_in, od_conv, od_w_out):
    rows = x.shape[1] // GRID_W
    lat_grid = (rows, GRID_W)
    ctx_grid = (1, ctx.shape[1])
    for layer in range(DEPTH):
        i = layer // 2
        even = layer % 2 == 0
        ctx_later = any(j % 2 == 0 for j in range(layer + 1, DEPTH))
        mod = [m[:, None, :] for m in jnp.split(jax.nn.silu(c) @ w_mod[layer] + b_mod[layer], 6, axis=-1)]
        gn = norm_g[layer]
        if even or ctx_later:
            mod_c = jnp.split(jax.nn.silu(c_ctx) @ w_mod[layer] + b_mod[layer], 6, axis=-1)
            hc = modulate(rmsnorm(ctx, gn[0]), mod_c[0], mod_c[1])
        h = modulate(rmsnorm(x, gn[0]), mod[0], mod[1])
        if even:
            y, y_ctx = even_mixer(h, hc, lat_grid, ctx_grid, ctx_later, ev_w_in[i], ev_w_out[i], ev_mu[i],
                                  ev_w0[i], ev_w_up[i], ev_a0[i], ev_a_up[i], ev_g_up[i], ev_k_k[i],
                                  ev_k_a[i], ev_r_k[i], ev_gn_w[i], ev_gn_b[i], ev_pool_w[i], ev_pool_scale[i])
        else:
            y = conv_mixer(h, od_w_in[i], od_conv[i], od_w_out[i], lat_grid)
            y_ctx = conv_mixer(hc, od_w_in[i], od_conv[i], od_w_out[i], ctx_grid) if ctx_later else None
        x = x + mod[2] * rmsnorm(y, gn[1])
        h = modulate(rmsnorm(x, gn[2]), mod[3], mod[4])
        x = x + mod[5] * rmsnorm(conv_ffn(h, ffn_w_up[layer], ffn_conv[layer], ffn_w_down[layer], lat_grid), gn[3])
        if ctx_later:
            ctx = ctx + mod_c[2] * rmsnorm(y_ctx, gn[1])
            hc = modulate(rmsnorm(ctx, gn[2]), mod_c[3], mod_c[4])
            ctx = ctx + mod_c[5] * rmsnorm(conv_ffn(hc, ffn_w_up[layer], ffn_conv[layer], ffn_w_down[layer], ctx_grid), gn[3])
    return x
```

```cpp
#include <hip/hip_runtime.h>
#include <hip/hip_bf16.h>
#include <hip/hip_cooperative_groups.h>
#include <cstdio>
namespace cg = cooperative_groups;

typedef unsigned short u16;
typedef _Float16 h16;
using bf16x8 = __attribute__((ext_vector_type(8))) short;
using f32x4 = __attribute__((ext_vector_type(4))) float;
using h16x4 = __attribute__((ext_vector_type(4))) _Float16;
using u16x4 = __attribute__((ext_vector_type(4))) unsigned short;
using u16x8 = __attribute__((ext_vector_type(8))) unsigned short;

#ifndef COOP
#define COOP 0
#endif

constexpr int D = 1024, NB = 8, SEQ = 4096, CTX = 256, DEPTH = 4;
constexpr int ML = NB * SEQ;
constexpr int MC = NB * CTX;
constexpr int MT = ML + MC;
constexpr int DFF = 2816;
constexpr int NEV = 2336, NEVP = 2432, DPROJ = 1824;
constexpr int LORA_K = 320, LORA_N = 2560;
constexpr float RMS_EPS = 1e-6f, GN_EPS = 64e-5f;

constexpr size_t SZ_FFNUP = 5632ull * 1024, SZ_FFNDN = 1024ull * 2816, SZ_EVIN = 2432ull * 1024, SZ_SQ = 1024ull * 1024,
                 SZ_LORA = 2560ull * 320, SZ_POOL = 512ull * 512, SZ_ODIN = 3072ull * 1024;
constexpr size_t OFF_FFNUP = 0;
constexpr size_t OFF_FFNDN = OFF_FFNUP + 4 * SZ_FFNUP;
constexpr size_t OFF_EVIN = OFF_FFNDN + 4 * SZ_FFNDN;
constexpr size_t OFF_EVOUT = OFF_EVIN + 2 * SZ_EVIN;
constexpr size_t OFF_LORA = OFF_EVOUT + 2 * SZ_SQ;
constexpr size_t OFF_POOL = OFF_LORA + 2 * SZ_LORA;
constexpr size_t OFF_ODIN = OFF_POOL + 2 * SZ_POOL;
constexpr size_t OFF_ODOUT = OFF_ODIN + 2 * SZ_ODIN;
constexpr size_t W_ELEMS = OFF_ODOUT + 2 * SZ_SQ;
constexpr size_t B_MOD = W_ELEMS * 2;
constexpr size_t B_XC = B_MOD + 4ull * 9 * 6144 * 4;
constexpr size_t B_KINV = B_XC + (size_t)MC * D * 4;
constexpr size_t B_ACT = B_KINV + (size_t)MT * 8 * 4;
constexpr size_t UU = (size_t)MT * 512 * 2;
#define ACT(p, u) ((p).ws + B_ACT + (size_t)(u) * UU)

struct Params {
  const float *x, *c, *ctx, *c_ctx, *w_mod, *b_mod, *norm_g, *ffn_w_up, *ffn_conv, *ffn_w_down,
      *ev_w_in, *ev_w_out, *ev_mu, *ev_w0, *ev_w_up, *ev_a0, *ev_a_up, *ev_g_up, *ev_k_k, *ev_k_a, *ev_r_k,
      *ev_gn_w, *ev_gn_b, *ev_pool_w, *ev_pool_scale, *od_w_in, *od_conv, *od_w_out;
  float* out;
  char* ws;
};

__device__ __forceinline__ u16 f2bf(float f) {
  unsigned u = __float_as_uint(f);
  u += 0x7fffu + ((u >> 16) & 1u);
  return (u16)(u >> 16);
}
__device__ __forceinline__ float bf2f(u16 h) { return __uint_as_float(((unsigned)h) << 16); }
__device__ __forceinline__ float sigmoidf_(float x) { return 1.f / (1.f + __expf(-x)); }
__device__ __forceinline__ float siluf_(float x) { return x / (1.f + __expf(-x)); }

template <int CTRL>
__device__ __forceinline__ float dppf(float x) {
  return __builtin_bit_cast(float, __builtin_amdgcn_update_dpp(0, __builtin_bit_cast(int, x), CTRL, 0xf, 0xf, false));
}
__device__ __forceinline__ float row16_sum(float x) {
  x += dppf<0x128>(x);
  x += dppf<0x124>(x);
  x += dppf<0x122>(x);
  x += dppf<0x121>(x);
  return x;
}
__device__ __forceinline__ float wave_sum(float x) {
  x = row16_sum(x);
  x += __shfl_xor(x, 16);
  x += __shfl_xor(x, 32);
  return x;
}

__device__ __forceinline__ int opaque_tid() { int t = threadIdx.x; asm volatile("" : "+v"(t)); return t; }
__device__ __forceinline__ int opaque_bid() { int t = blockIdx.x; asm volatile("" : "+s"(t)); return t; }
__device__ __forceinline__ int vblock(int bid) { return (bid & 7) * (gridDim.x >> 3) + (bid >> 3); }

__device__ __forceinline__ int map_col(int kind, int nd, int srcN) {
  if (kind == 0) return nd < srcN ? nd : -1;
  if (kind == 1) {
    int t = nd >> 7, r = nd & 127, wc = r >> 6, half = (r >> 5) & 1, j = r & 31;
    return half * DFF + t * 64 + wc * 32 + j;
  }
  int t = nd / 96, r = nd % 96, wc = r / 48, part = (r % 48) >> 4, j = r & 15;
  return part * 1024 + t * 32 + wc * 16 + j;
}

__device__ void conv_tile(const float* __restrict__ src, int srcN, int K, u16* __restrict__ dst, int kind, int tile,
                          int ntn64, float* sT) {
  const int TIDX = opaque_tid(); const int BIDX = opaque_bid(); (void)TIDX; (void)BIDX;
  int tn = tile % ntn64, tk = tile / ntn64;
  int n0 = tn * 64, k0 = tk * 64;
  int tx = TIDX & 63, ty = TIDX >> 6;
  int sc = map_col(kind, n0 + tx, srcN);
#pragma unroll 4
  for (int kk = ty; kk < 64; kk += 4) {
    float v = sc >= 0 ? src[(size_t)(k0 + kk) * srcN + sc] : 0.f;
    sT[kk * 65 + tx] = v;
  }
  __syncthreads();
  int n = TIDX >> 2, kq = (TIDX & 3) * 16;
  u16x8 o0, o1;
#pragma unroll
  for (int e = 0; e < 8; ++e) {
    o0[e] = f2bf(sT[(kq + e) * 65 + n]);
    o1[e] = f2bf(sT[(kq + 8 + e) * 65 + n]);
  }
  u16* d = dst + (size_t)(n0 + n) * K + k0 + kq;
  *(u16x8*)d = o0;
  *(u16x8*)(d + 8) = o1;
  __syncthreads();
}

__device__ __forceinline__ void pre_phase(const Params& p, char* smem) {
  const int TIDX = opaque_tid(); const int BIDX = opaque_bid(); (void)TIDX; (void)BIDX;
  u16* W = (u16*)p.ws;
  float* sT = (float*)smem;
  constexpr int T_UP = 88 * 16, T_DN = 16 * 44, T_EVIN = 38 * 16, T_SQ = 256, T_ODIN = 48 * 16;
  constexpr int N_BIG = 4 * T_UP + 4 * T_DN + 2 * (T_EVIN + T_SQ + T_ODIN + T_SQ);
  constexpr int N_LORA = 200, N_POOL = 64;
  constexpr int N_SMALL = 2 * (N_LORA + N_POOL);
  constexpr int N_MOD = 4 * 96;
  constexpr int N_ALL = N_BIG + N_SMALL + N_MOD;
  for (int it = BIDX; it < N_ALL; it += gridDim.x) {
    if (it < N_MOD) {
      int l = it / 96, c0 = (it % 96) * 64;
      float* sS = (float*)smem;
      float* sR = sS + 9 * 1024;
      for (int e = TIDX; e < 9 * 1024; e += 256) {
        int j = e >> 10, k = e & 1023;
        float cv = j < 8 ? p.c[j * 1024 + k] : p.c_ctx[k];
        sS[e] = siluf_(cv);
      }
      __syncthreads();
      int w = TIDX >> 6, lane = TIDX & 63;
      float acc[9];
#pragma unroll
      for (int j = 0; j < 9; ++j) acc[j] = 0.f;
      const float* wm = p.w_mod + (size_t)l * 1024 * 6144 + c0 + lane;
#pragma unroll 8
      for (int k = w * 256; k < w * 256 + 256; ++k) {
        float wv = wm[(size_t)k * 6144];
#pragma unroll
        for (int j = 0; j < 9; ++j) acc[j] += sS[j * 1024 + k] * wv;
      }
#pragma unroll
      for (int j = 0; j < 9; ++j) sR[(w * 9 + j) * 64 + lane] = acc[j];
      __syncthreads();
      for (int e = TIDX; e < 9 * 64; e += 256) {
        int j = e >> 6, cc = e & 63;
        float s = sR[(0 * 9 + j) * 64 + cc] + sR[(1 * 9 + j) * 64 + cc] + sR[(2 * 9 + j) * 64 + cc] + sR[(3 * 9 + j) * 64 + cc];
        s += p.b_mod[l * 6144 + c0 + cc];
        ((float*)(p.ws + B_MOD))[(size_t)(l * 9 + j) * 6144 + c0 + cc] = s;
      }
      __syncthreads();
      continue;
    }
    int t = it - N_MOD;
    if (t < N_BIG) {
      if (t < 4 * T_UP) {
        int l = t / T_UP;
        conv_tile(p.ffn_w_up + (size_t)l * 1024 * 5632, 5632, 1024, W + OFF_FFNUP + l * SZ_FFNUP, 1, t % T_UP, 88, sT);
        continue;
      }
      t -= 4 * T_UP;
      if (t < 4 * T_DN) {
        int l = t / T_DN;
        conv_tile(p.ffn_w_down + (size_t)l * 2816 * 1024, 1024, 2816, W + OFF_FFNDN + l * SZ_FFNDN, 0, t % T_DN, 16, sT);
        continue;
      }
      t -= 4 * T_DN;
      if (t < 2 * T_EVIN) {
        int i = t / T_EVIN;
        conv_tile(p.ev_w_in + (size_t)i * 1024 * NEV, NEV, 1024, W + OFF_EVIN + i * SZ_EVIN, 0, t % T_EVIN, 38, sT);
        continue;
      }
      t -= 2 * T_EVIN;
      if (t < 2 * T_SQ) {
        int i = t / T_SQ;
        conv_tile(p.ev_w_out + (size_t)i * SZ_SQ, 1024, 1024, W + OFF_EVOUT + i * SZ_SQ, 0, t % T_SQ, 16, sT);
        continue;
      }
      t -= 2 * T_SQ;
      if (t < 2 * T_ODIN) {
        int i = t / T_ODIN;
        conv_tile(p.od_w_in + (size_t)i * 1024 * 3072, 3072, 1024, W + OFF_ODIN + i * SZ_ODIN, 2, t % T_ODIN, 48, sT);
        continue;
      }
      t -= 2 * T_ODIN;
      {
        int i = t / T_SQ;
        conv_tile(p.od_w_out + (size_t)i * SZ_SQ, 1024, 1024, W + OFF_ODOUT + i * SZ_SQ, 0, t % T_SQ, 16, sT);
        continue;
      }
    }
    t -= N_BIG;
    {
      int i = t / (N_LORA + N_POOL);
      int r = t % (N_LORA + N_POOL);
      if (r < N_LORA) {
        u16* dst = W + OFF_LORA + i * SZ_LORA;
        for (int e = r * 4096 + TIDX; e < r * 4096 + 4096; e += 256) {
          int n = e / LORA_K, k = e % LORA_K;
          int seg = n >> 9, cc = n & 511;
          float v = 0.f;
          if (seg == 0) { if (k < 32) v = p.ev_w_up[((size_t)(i * 2 + 0) * 32 + k) * 512 + cc]; }
          else if (seg == 1) { if (k >= 32 && k < 64) v = p.ev_w_up[((size_t)(i * 2 + 1) * 32 + (k - 32)) * 512 + cc]; }
          else if (seg == 2) { if (k >= 64 && k < 128) v = p.ev_a_up[((size_t)(i * 2 + 0) * 64 + (k - 64)) * 512 + cc]; }
          else if (seg == 3) { if (k >= 128 && k < 192) v = p.ev_a_up[((size_t)(i * 2 + 1) * 64 + (k - 128)) * 512 + cc]; }
          else { if (k >= 192 && k < 288) v = p.ev_g_up[((size_t)i * 96 + (k - 192)) * 512 + cc]; }
          dst[e] = f2bf(v);
        }
      } else {
        r -= N_LORA;
        u16* dst = W + OFF_POOL + i * SZ_POOL;
        for (int e = r * 4096 + TIDX; e < r * 4096 + 4096; e += 256) {
          int n = e >> 9, k = e & 511;
          float v = 0.f;
          int g = n >> 7;
          if ((k >> 7) == g) v = p.ev_pool_w[(((size_t)i * 4 + g) * 128 + (k & 127)) * 128 + (n & 127)] * p.ev_pool_scale[i * 512 + n];
          dst[e] = f2bf(v);
        }
      }
    }
  }
}

__device__ __forceinline__ void row_phase(const Params& p, const bool HAS_Y, const bool HAS_H, int nrows, const u16* __restrict__ Y, const float* __restrict__ modg  ,
                          int gate_chunk, const float* __restrict__ gy, const float* __restrict__ gx,
                          const float* __restrict__ modh  , int shift_chunk, u16* __restrict__ H) {
  const int TIDX = opaque_tid(); const int BIDX = opaque_bid(); (void)TIDX; (void)BIDX;
  int lane = TIDX & 63;
  int gw = BIDX * 4 + (TIDX >> 6), nw = gridDim.x * 4;
  float* XC = (float*)(p.ws + B_XC);
  for (int row = gw; row < nrows; row += nw) {
    int b = row < ML ? (row >> 12) : 8;
    float* xr = row < ML ? p.out + (size_t)row * D : XC + (size_t)(row - ML) * D;
    float4 xv[4];
    if (HAS_Y) {
#pragma unroll
      for (int i = 0; i < 4; ++i) xv[i] = *(const float4*)(xr + i * 256 + lane * 4);
      float yv[16];
      float ss = 0.f;
#pragma unroll
      for (int i = 0; i < 4; ++i) {
        u16x4 t = *(const u16x4*)(Y + (size_t)row * D + i * 256 + lane * 4);
#pragma unroll
        for (int e = 0; e < 4; ++e) { yv[i * 4 + e] = bf2f(t[e]); ss += yv[i * 4 + e] * yv[i * 4 + e]; }
      }
      ss = wave_sum(ss);
      float rstd = rsqrtf(ss * (1.f / D) + RMS_EPS);
#pragma unroll
      for (int i = 0; i < 4; ++i) {
        int c = i * 256 + lane * 4;
        float4 g4 = *(const float4*)(gy + c);
        float4 gt = *(const float4*)(modg + (size_t)b * 6144 + gate_chunk * 1024 + c);
        xv[i].x += gt.x * (yv[i * 4 + 0] * rstd * g4.x);
        xv[i].y += gt.y * (yv[i * 4 + 1] * rstd * g4.y);
        xv[i].z += gt.z * (yv[i * 4 + 2] * rstd * g4.z);
        xv[i].w += gt.w * (yv[i * 4 + 3] * rstd * g4.w);
      }
    } else {
      const float* src = row < ML ? p.x + (size_t)row * D : p.ctx + (size_t)(row - ML) * D;
#pragma unroll
      for (int i = 0; i < 4; ++i) xv[i] = *(const float4*)(src + i * 256 + lane * 4);
    }
#pragma unroll
    for (int i = 0; i < 4; ++i) *(float4*)(xr + i * 256 + lane * 4) = xv[i];
    if (HAS_H) {
      float ss = 0.f;
#pragma unroll
      for (int i = 0; i < 4; ++i) ss += xv[i].x * xv[i].x + xv[i].y * xv[i].y + xv[i].z * xv[i].z + xv[i].w * xv[i].w;
      ss = wave_sum(ss);
      float rstd = rsqrtf(ss * (1.f / D) + RMS_EPS);
#pragma unroll
      for (int i = 0; i < 4; ++i) {
        int c = i * 256 + lane * 4;
        float4 g4 = *(const float4*)(gx + c);
        float4 sh = *(const float4*)(modh + (size_t)b * 6144 + shift_chunk * 1024 + c);
        float4 sc = *(const float4*)(modh + (size_t)b * 6144 + (shift_chunk + 1) * 1024 + c);
        u16x4 o;
        o[0] = f2bf(xv[i].x * rstd * g4.x * (1.f + sc.x) + sh.x);
        o[1] = f2bf(xv[i].y * rstd * g4.y * (1.f + sc.y) + sh.y);
        o[2] = f2bf(xv[i].z * rstd * g4.z * (1.f + sc.z) + sh.z);
        o[3] = f2bf(xv[i].w * rstd * g4.w * (1.f + sc.w) + sh.w);
        *(u16x4*)(H + (size_t)row * D + c) = o;
      }
    }
  }
}

enum { EPI_BF16 = 0, EPI_FFN = 1, EPI_ODD = 2, EPI_LORA = 3 };

struct GemmP {
  const u16* A1; const u16* A2; int lda1, lda2, ksplit;
  const u16* Bt; int K; int ntn; int mtiles; int conv;
  u16* C; int ldc;
  const float* cw;
  int cwC;
  const float* w0; const float* a0; h16* lout;
};

__device__ __forceinline__ bool seg_start(int a) { return a < ML ? ((a & 63) == 0) : (((a - ML) & 255) == 0); }
__device__ __forceinline__ bool seg_end(int a) { return a < ML ? ((a & 63) == 63) : (((a - ML) & 255) == 255); }

template <int NT, int EPI>
__device__ __forceinline__ void gemm_phase(const GemmP& g, char* smem) {
  const int TIDX = opaque_tid(); const int BIDX = opaque_bid(); (void)TIDX; (void)BIDX;
  constexpr int BN = 32 * NT;
  u16* SA = (u16*)smem;
  u16* SB = (u16*)(smem + 8192);
  const int tid = TIDX, wid = tid >> 6, lane = tid & 63, wr = wid >> 1, wc = wid & 1, fr = lane & 15, fq = lane >> 4;
  const int ntiles = g.mtiles * g.ntn;
  const int sr = tid >> 2, scol = (tid & 3) * 8;
#pragma unroll 1
  for (int tile = vblock(BIDX); tile < ntiles; tile += gridDim.x) {
    int mt = tile / g.ntn, nt = tile % g.ntn;
    int row0, vlo = 0, vhi = 128, vend = MT;
    if (!g.conv || mt < 256) {
      row0 = mt * 128;
    } else {
      int s = (mt - 256) / 3, j = (mt - 256) % 3;
      int base = ML + s * 256;
      row0 = base + 126 * j - 1; vlo = 1; vhi = 127; vend = base + 256;
    }
    int n0 = nt * BN;
    f32x4 acc[4][NT];
#pragma unroll
    for (int m = 0; m < 4; ++m)
#pragma unroll
      for (int n = 0; n < NT; ++n) acc[m][n] = f32x4{0.f, 0.f, 0.f, 0.f};
    int ga0 = min(row0 + sr, MT - 1), ga1 = min(row0 + sr + 64, MT - 1);
    const int nk = g.K >> 5;
#pragma unroll 1
    for (int t = 0; t < nk; ++t) {
      int k0 = t << 5;
      const u16* Ab; int lda;
      if (k0 < g.ksplit) { Ab = g.A1 + k0; lda = g.lda1; } else { Ab = g.A2 + (k0 - g.ksplit); lda = g.lda2; }
      __builtin_amdgcn_global_load_lds((const unsigned*)(Ab + (size_t)ga0 * lda + scol), (unsigned*)((char*)SA + tid * 16), 16, 0, 0);
      __builtin_amdgcn_global_load_lds((const unsigned*)(Ab + (size_t)ga1 * lda + scol), (unsigned*)((char*)SA + tid * 16 + 4096), 16, 0, 0);
      const u16* Bb = g.Bt + (size_t)n0 * g.K + k0 + scol;
      __builtin_amdgcn_global_load_lds((const unsigned*)(Bb + (size_t)sr * g.K), (unsigned*)((char*)SB + tid * 16), 16, 0, 0);
      if (NT == 4 || tid < 128)
        __builtin_amdgcn_global_load_lds((const unsigned*)(Bb + (size_t)(sr + 64) * g.K), (unsigned*)((char*)SB + tid * 16 + 4096), 16, 0, 0);
      asm volatile("s_waitcnt vmcnt(0)" ::: "memory");
      __syncthreads();
      bf16x8 At[4], Bf[NT];
#pragma unroll
      for (int m = 0; m < 4; ++m) At[m] = *(const bf16x8*)(SA + (wr * 64 + m * 16 + fr) * 32 + fq * 8);
#pragma unroll
      for (int n = 0; n < NT; ++n) Bf[n] = *(const bf16x8*)(SB + (wc * 16 * NT + n * 16 + fr) * 32 + fq * 8);
#pragma unroll
      for (int m = 0; m < 4; ++m)
#pragma unroll
        for (int n = 0; n < NT; ++n) acc[m][n] = __builtin_amdgcn_mfma_f32_16x16x32_bf16(At[m], Bf[n], acc[m][n], 0, 0, 0);
      __syncthreads();
    }
    if (EPI == EPI_BF16) {
#pragma unroll
      for (int m = 0; m < 4; ++m)
#pragma unroll
        for (int j = 0; j < 4; ++j) {
          int r = wr * 64 + m * 16 + fq * 4 + j;
          size_t ro = (size_t)(row0 + r) * g.ldc + n0 + wc * 16 * NT + fr;
#pragma unroll
          for (int n = 0; n < NT; ++n) g.C[ro + n * 16] = f2bf(acc[m][n][j]);
        }
    } else if (EPI == EPI_LORA) {
      int seg = n0 >> 9;
      h16* dst = g.lout + (size_t)seg * MT * 512;
#pragma unroll
      for (int n = 0; n < NT; ++n) {
        int cc = (n0 & 511) + wc * 16 * NT + n * 16 + fr;
        float bias = seg < 2 ? g.w0[seg * 512 + cc] : (seg < 4 ? g.a0[(seg - 2) * 512 + cc] : 0.f);
#pragma unroll
        for (int m = 0; m < 4; ++m)
#pragma unroll
          for (int j = 0; j < 4; ++j) {
            int r = wr * 64 + m * 16 + fq * 4 + j;
            float v = acc[m][n][j] + bias, o;
            if (seg < 2) {
              float sp = (-v > 20.f) ? -v : log1pf(__expf(-v));
              o = -__expf(-sp - 0.5f);
            } else if (seg < 4) {
              o = sigmoidf_(v);
            } else {
              o = v;
            }
            dst[(size_t)(row0 + r) * 512 + cc] = (h16)o;
          }
      }
    } else {
      constexpr int CW = (EPI == EPI_FFN) ? 64 : 32;
      constexpr int CPW = CW / 2;
      constexpr int NA = CPW / 16;
      float* sC = (float*)smem;
#pragma unroll
      for (int m = 0; m < 4; ++m)
#pragma unroll
        for (int n = 0; n < NA; ++n)
#pragma unroll
          for (int j = 0; j < 4; ++j) {
            int r = wr * 64 + m * 16 + fq * 4 + j;
            float u = (EPI == EPI_FFN) ? acc[m][n][j] : acc[m][1][j] * acc[m][2][j];
            sC[r * CW + wc * CPW + n * 16 + fr] = u;
          }
      __syncthreads();
#pragma unroll
      for (int n = 0; n < NA; ++n) {
        int cl = wc * CPW + n * 16 + fr;
        int ch = nt * CW + cl;
        float c0 = g.cw[ch], c1 = g.cw[g.cwC + ch], c2 = g.cw[2 * g.cwC + ch];
#pragma unroll
        for (int m = 0; m < 4; ++m)
#pragma unroll
          for (int j = 0; j < 4; ++j) {
            int r = wr * 64 + m * 16 + fq * 4 + j;
            int a = row0 + r;
            float cur = sC[r * CW + cl];
            float pv = (r > 0 && !seg_start(a)) ? sC[(r - 1) * CW + cl] : 0.f;
            float nv = (r < 127 && !seg_end(a)) ? sC[(r + 1) * CW + cl] : 0.f;
            float cv = c0 * pv + c1 * cur + c2 * nv;
            float o = (EPI == EPI_FFN) ? siluf_(cv) * acc[m][n + 2][j] : acc[m][0][j] * cv;
            if (r >= vlo && r < vhi && a < vend) g.C[(size_t)a * g.ldc + ch] = f2bf(o);
          }
      }
      __syncthreads();
    }
  }
}

__device__ __forceinline__ void prep1_phase(const Params& p, int i, int nrows, const u16* __restrict__ P, h16* __restrict__ R, h16* __restrict__ Kk,
                            h16* __restrict__ V, u16* __restrict__ L, u16* __restrict__ Dp) {
  const int TIDX = opaque_tid(); const int BIDX = opaque_bid(); (void)TIDX; (void)BIDX;
  int lane = TIDX & 63;
  int gw = BIDX * 4 + (TIDX >> 6), nw = gridDim.x * 4;
  const float* mu0 = p.ev_mu + (size_t)i * 2 * DPROJ;
  const float* mu1 = mu0 + DPROJ;
  const float* k_k = p.ev_k_k + i * 512;
  float* KINV = (float*)(p.ws + B_KINV);
  for (int row = gw; row < nrows; row += nw) {
    bool lat = row < ML;
    int t = lat ? (row & 4095) : ((row - ML) & 255);
    int tl = lat ? 4095 : 255;
    bool hp = t > 0, hn = t < tl;
    const u16* pc = P + (size_t)row * NEVP;
    const u16* pp = pc - NEVP;
    const u16* pn = pc + NEVP;
    for (int q = 0; q < 24; ++q) {
      int c = q * 64 + lane;
      float cur = bf2f(pc[c]);
      float pv = hp ? bf2f(pp[c]) : 0.f;
      float nv = hn ? bf2f(pn[c]) : 0.f;
      float s = cur + mu0[c] * (pv - cur) + mu1[c] * (nv - cur);
      if (q < 8) {
        R[(size_t)row * 512 + c] = (h16)s;
      } else if (q < 16) {
        int cc = c - 512;
        Kk[(size_t)row * 512 + cc] = (h16)s;
        float kr = s * k_k[cc];
        float ss = wave_sum(kr * kr);
        if (lane == 0) KINV[(size_t)row * 8 + (q - 8)] = rsqrtf(fmaxf(ss, 1e-24f));
      } else {
        V[(size_t)row * 512 + (c - 1024)] = (h16)s;
      }
    }
    for (int q = 0; q < 5; ++q) {
      int j = q * 64 + lane;
      if (j < LORA_K) {
        float o = 0.f;
        if (j < 288) {
          int c = 1536 + j;
          float cur = bf2f(pc[c]);
          float pv = hp ? bf2f(pp[c]) : 0.f;
          float nv = hn ? bf2f(pn[c]) : 0.f;
          float s = cur + mu0[c] * (pv - cur) + mu1[c] * (nv - cur);
          o = j < 64 ? tanhf(s) : (j < 192 ? s : sigmoidf_(s));
        }
        L[(size_t)row * LORA_K + j] = f2bf(o);
      }
    }
    int pos = lat ? (row & 63) : ((row - ML) & 255);
    int Lr = lat ? 64 : 256;
    for (int q = 0; q < 8; ++q) {
      int cc = q * 64 + lane;
      int half = 1 << (q >> 1);
      int lo = max(pos - half, 0), hi = min(pos + half, Lr);
      float sum = 0.f;
      for (int jj = lo; jj < hi; ++jj) sum += bf2f(pc[(ptrdiff_t)(jj - pos) * NEVP + DPROJ + cc]);
      float mean = sum / (float)(hi - lo);
      float d = mean - bf2f(pc[DPROJ + cc]);
      Dp[(size_t)row * 512 + cc] = f2bf(d);
    }
  }
}

__device__ __forceinline__ void scan_phase(const Params& p, int i, const h16* __restrict__ R, const h16* __restrict__ Kk, const h16* __restrict__ V,
                           const h16* __restrict__ W0, const h16* __restrict__ W1, const h16* __restrict__ A0,
                           const h16* __restrict__ A1, u16* __restrict__ Y0, u16* __restrict__ Y1, char* smem) {
  const int TIDX = opaque_tid(); const int BIDX = opaque_bid(); (void)TIDX; (void)BIDX;
  const int tid = TIDX, wid = tid >> 6, lane = tid & 63;
  const int grp = lane >> 4, j16 = lane & 15;
  const float* KINV = (const float*)(p.ws + B_KINV);
  float* sOp = (float*)smem;
  for (int item = BIDX; item < 256; item += gridDim.x) {
    int half = item & 1, dir = (item >> 1) & 1, h = (item >> 2) & 7, b = item >> 5;
    const h16* Wd = dir ? W1 : W0;
    const h16* Ad = dir ? A1 : A0;
    u16* Yd = dir ? Y1 : Y0;
    int ss = tid >> 4, c4 = (tid & 15) * 4;
    float kkp[4], kap[4];
#pragma unroll
    for (int e = 0; e < 4; ++e) { kkp[e] = p.ev_k_k[i * 512 + h * 64 + c4 + e]; kap[e] = p.ev_k_a[i * 512 + h * 64 + c4 + e]; }
    int rowA = half * 32 + wid * 8 + grp * 2;
    float S[2][4];
#pragma unroll
    for (int rr = 0; rr < 2; ++rr)
#pragma unroll
      for (int e = 0; e < 4; ++e) S[rr][e] = 0.f;

    auto tok_row = [&](int cidx, int s) -> int {
      if (cidx < 16) { int q = cidx * 16 + s; int tk = dir ? 255 - q : q; return ML + b * 256 + tk; }
      int q = (cidx - 16) * 16 + s; int tk = dir ? 4095 - q : q; return b * 4096 + tk;
    };
    h16x4 lr, lk, lv, lw, la; float linv;
    auto gload = [&](int cidx) {
      size_t o = (size_t)tok_row(cidx, ss) * 512 + h * 64 + c4;
      lr = *(const h16x4*)(R + o); lk = *(const h16x4*)(Kk + o); lv = *(const h16x4*)(V + o);
      lw = *(const h16x4*)(Wd + o); la = *(const h16x4*)(Ad + o);
      linv = KINV[(size_t)tok_row(cidx, ss) * 8 + h];
    };
    auto lstore = [&](int buf) {
      float* base = sOp + (size_t)buf * 16 * 6 * 64 + ss * 6 * 64 + c4;
      float4 kk4, w4, b4, kd4, r4, v4;
      float* kkf = (float*)&kk4; float* wf = (float*)&w4; float* bfp = (float*)&b4; float* kdf = (float*)&kd4;
      float* rf = (float*)&r4; float* vf = (float*)&v4;
#pragma unroll
      for (int e = 0; e < 4; ++e) {
        float k = (float)lk[e], a = (float)la[e];
        float kk = k * kkp[e] * linv;
        kkf[e] = kk;
        wf[e] = __expf((float)lw[e]);
        bfp[e] = kk * a;
        kdf[e] = k * (1.f + (a - 1.f) * kap[e]);
        rf[e] = (float)lr[e];
        vf[e] = (float)lv[e];
      }
      *(float4*)(base + 0 * 64) = kk4; *(float4*)(base + 1 * 64) = w4; *(float4*)(base + 2 * 64) = b4;
      *(float4*)(base + 3 * 64) = kd4; *(float4*)(base + 4 * 64) = r4; *(float4*)(base + 5 * 64) = v4;
    };
    __syncthreads();
    gload(0);
    lstore(0);
    __syncthreads();
    constexpr int NCH = 16 + 256;
    for (int cidx = 0; cidx < NCH; ++cidx) {
      int buf = cidx & 1;
      if (cidx + 1 < NCH) gload(cidx + 1);
      const float* cb = sOp + (size_t)buf * 16 * 6 * 64;
      float yk0 = 0.f, yk1 = 0.f;
#pragma unroll 4
      for (int s = 0; s < 16; ++s) {
        const float* sb = cb + s * 6 * 64;
        float4 kk4 = *(const float4*)(sb + 0 * 64 + j16 * 4);
        float4 w4 = *(const float4*)(sb + 1 * 64 + j16 * 4);
        float4 b4 = *(const float4*)(sb + 2 * 64 + j16 * 4);
        float4 kd4 = *(const float4*)(sb + 3 * 64 + j16 * 4);
        float4 r4 = *(const float4*)(sb + 4 * 64 + j16 * 4);
        float v0 = sb[5 * 64 + rowA], v1 = sb[5 * 64 + rowA + 1];
        float sa0 = S[0][0] * kk4.x + S[0][1] * kk4.y + S[0][2] * kk4.z + S[0][3] * kk4.w;
        float sa1 = S[1][0] * kk4.x + S[1][1] * kk4.y + S[1][2] * kk4.z + S[1][3] * kk4.w;
        sa0 = row16_sum(sa0);
        sa1 = row16_sum(sa1);
        S[0][0] = S[0][0] * w4.x - sa0 * b4.x + v0 * kd4.x;
        S[0][1] = S[0][1] * w4.y - sa0 * b4.y + v0 * kd4.y;
        S[0][2] = S[0][2] * w4.z - sa0 * b4.z + v0 * kd4.z;
        S[0][3] = S[0][3] * w4.w - sa0 * b4.w + v0 * kd4.w;
        S[1][0] = S[1][0] * w4.x - sa1 * b4.x + v1 * kd4.x;
        S[1][1] = S[1][1] * w4.y - sa1 * b4.y + v1 * kd4.y;
        S[1][2] = S[1][2] * w4.z - sa1 * b4.z + v1 * kd4.z;
        S[1][3] = S[1][3] * w4.w - sa1 * b4.w + v1 * kd4.w;
        float y0 = S[0][0] * r4.x + S[0][1] * r4.y + S[0][2] * r4.z + S[0][3] * r4.w;
        float y1 = S[1][0] * r4.x + S[1][1] * r4.y + S[1][2] * r4.z + S[1][3] * r4.w;
        y0 = row16_sum(y0);
        y1 = row16_sum(y1);
        if (j16 == s) { yk0 = y0; yk1 = y1; }
      }
      {
        size_t o = (size_t)tok_row(cidx, j16) * 512 + h * 64 + rowA;
        unsigned pk = (unsigned)f2bf(yk0) | ((unsigned)f2bf(yk1) << 16);
        *(unsigned*)(Yd + o) = pk;
      }
      if (cidx + 1 < NCH) lstore(buf ^ 1);
      __syncthreads();
    }
  }
}

__device__ __forceinline__ void merge_phase(const Params& p, int i, int nrows, const h16* __restrict__ R, const h16* __restrict__ Kk,
                            const h16* __restrict__ V, const h16* __restrict__ A0, const h16* __restrict__ A1,
                            const h16* __restrict__ Gt, u16* Y0, const u16* __restrict__ Y1) {
  const int TIDX = opaque_tid(); const int BIDX = opaque_bid(); (void)TIDX; (void)BIDX;
  int lane = TIDX & 63;
  int gw = BIDX * 4 + (TIDX >> 6), nw = gridDim.x * 4;
  for (int row = gw; row < nrows; row += nw) {
    for (int h = 0; h < 8; ++h) {
      int c = h * 64 + lane;
      size_t o = (size_t)row * 512 + c;
      float y = bf2f(Y0[o]) + bf2f(Y1[o]);
      float mean = wave_sum(y) * (1.f / 64.f);
      float yc = y - mean;
      float var = wave_sum(yc * yc) * (1.f / 64.f);
      float yn = yc * rsqrtf(var + GN_EPS) * p.ev_gn_w[i * 512 + c] + p.ev_gn_b[i * 512 + c];
      float k = (float)Kk[o], a0 = (float)A0[o], a1 = (float)A1[o], r = (float)R[o], v = (float)V[o], g = (float)Gt[o];
      float kdsum = k * (2.f + (a0 + a1 - 2.f) * p.ev_k_a[i * 512 + c]);
      float coef = wave_sum(r * kdsum * p.ev_r_k[i * 512 + c]);
      float outv = (yn + coef * v) * g;
      Y0[o] = f2bf(outv);
    }
  }
}

constexpr int NPHASES = 34;
enum { T_PRE = 0, T_ROW, T_GEMM_BF16, T_PREP1, T_LORA, T_SCAN, T_MERGE, T_FFN, T_ODD };

__global__ void __launch_bounds__(256, 2) mega(Params p, int ph_lo, int ph_hi, int coop) {
  __shared__ __attribute__((aligned(16))) char smem[49152];
  cg::grid_group grid = cg::this_grid();
  const u16* W = (const u16*)p.ws;
  const float* MOD = (const float*)(p.ws + B_MOD);
  u16* H = (u16*)ACT(p, 0);
  u16* Y = (u16*)ACT(p, 2);
  u16* G = (u16*)ACT(p, 4);
  u16* P = (u16*)ACT(p, 6);
  h16* Rr = (h16*)ACT(p, 2);
  h16* Kk = (h16*)ACT(p, 3);
  h16* Vv = (h16*)ACT(p, 4);
  u16* Dp = (u16*)ACT(p, 5);
  u16* L = (u16*)ACT(p, 0);
  h16* LO = (h16*)ACT(p, 6);
  u16* YP = (u16*)ACT(p, 1);
  u16* Y0 = (u16*)ACT(p, 0);
  u16* Y1 = (u16*)ACT(p, 5);
  u16* G1 = (u16*)ACT(p, 4);

#pragma unroll 1
  for (int ph = ph_lo; ph < ph_hi; ++ph) {
    int type, l = 0, pos = 0;
    if (ph == 0) type = T_PRE;
    else if (ph == 1) { type = T_ROW; pos = -1; }
    else {
      if (ph < 12) { l = 0; pos = ph - 2; }
      else if (ph < 18) { l = 1; pos = ph - 12; }
      else if (ph < 28) { l = 2; pos = ph - 18; }
      else { l = 3; pos = ph - 28; }
      if (l & 1) pos = pos == 0 ? 10 : (pos == 1 ? 5 : pos + 4);
      type = pos == 0 ? T_GEMM_BF16 : pos == 1 ? T_PREP1 : pos == 2 ? T_LORA : pos == 3 ? T_SCAN : pos == 4 ? T_MERGE
           : pos == 5 ? T_GEMM_BF16 : pos == 6 ? T_ROW : pos == 7 ? T_FFN : pos == 8 ? T_GEMM_BF16 : pos == 9 ? T_ROW : T_ODD;
    }
    const int i = l >> 1;
    const bool even = (l & 1) == 0;
    const bool ctx_later = l < 2;
    const bool ctx_in = l <= 2;
    const float* MODL = MOD + (size_t)l * 9 * 6144;
    const float* gn = p.norm_g + (size_t)l * 4 * D;
    GemmP g{};
    g.conv = 0;
    if (pos == 0) {
      g.A1 = H; g.A2 = H; g.lda1 = D; g.lda2 = D; g.ksplit = D; g.Bt = W + OFF_EVIN + i * SZ_EVIN; g.K = D;
      g.ntn = NEVP / 128; g.mtiles = ctx_in ? 272 : 256; g.C = P; g.ldc = NEVP;
    } else if (pos == 2) {
      g.A1 = L; g.A2 = L; g.lda1 = LORA_K; g.lda2 = LORA_K; g.ksplit = LORA_K; g.Bt = W + OFF_LORA + i * SZ_LORA; g.K = LORA_K;
      g.ntn = LORA_N / 128; g.mtiles = ctx_in ? 272 : 256;
      g.w0 = p.ev_w0 + i * 1024; g.a0 = p.ev_a0 + i * 1024; g.lout = LO;
    } else if (pos == 5) {
      if (even) { g.A1 = Y0; g.A2 = YP; g.lda1 = 512; g.lda2 = 512; g.ksplit = 512; g.Bt = W + OFF_EVOUT + i * SZ_SQ; }
      else { g.A1 = G1; g.A2 = G1; g.lda1 = D; g.lda2 = D; g.ksplit = D; g.Bt = W + OFF_ODOUT + i * SZ_SQ; }
      g.K = D; g.ntn = 8; g.mtiles = ctx_later ? 272 : 256; g.C = Y; g.ldc = D;
    } else if (pos == 7) {
      g.A1 = H; g.A2 = H; g.lda1 = D; g.lda2 = D; g.ksplit = D; g.Bt = W + OFF_FFNUP + l * SZ_FFNUP; g.K = D;
      g.ntn = 44; g.mtiles = ctx_later ? 280 : 256; g.conv = 1; g.C = G; g.ldc = DFF;
      g.cw = p.ffn_conv + (size_t)l * 3 * DFF; g.cwC = DFF;
    } else if (pos == 8) {
      g.A1 = G; g.A2 = G; g.lda1 = DFF; g.lda2 = DFF; g.ksplit = DFF; g.Bt = W + OFF_FFNDN + l * SZ_FFNDN; g.K = DFF;
      g.ntn = 8; g.mtiles = ctx_later ? 272 : 256; g.C = Y; g.ldc = D;
    } else if (pos == 10) {
      g.A1 = H; g.A2 = H; g.lda1 = D; g.lda2 = D; g.ksplit = D; g.Bt = W + OFF_ODIN + i * SZ_ODIN; g.K = D;
      g.ntn = 32; g.mtiles = ctx_later ? 280 : 256; g.conv = 1; g.C = G1; g.ldc = D;
      g.cw = p.od_conv + (size_t)i * 3 * D; g.cwC = D;
    }
    switch (type) {
      case T_PRE: pre_phase(p, smem); break;
      case T_ROW:
        if (pos == -1) row_phase(p, false, true, MT, nullptr, MOD, 0, p.norm_g, p.norm_g, MOD, 0, H);
        else if (pos == 6) row_phase(p, true, true, ctx_later ? MT : ML, Y, MODL, 2, gn + D, gn + 2 * D, MODL, 3, H);
        else row_phase(p, true, l < DEPTH - 1, ctx_later ? MT : ML, Y, MODL, 5, gn + 3 * D, gn + (l < DEPTH - 1 ? 4 * D : 0),
                       MODL + (l < DEPTH - 1 ? 9 * 6144 : 0), 0, H);
        break;
      case T_PREP1: prep1_phase(p, i, ctx_in ? MT : ML, P, Rr, Kk, Vv, L, Dp); break;
      case T_LORA:
        gemm_phase<4, EPI_LORA>(g, smem);
        g.A1 = Dp; g.A2 = Dp; g.lda1 = 512; g.lda2 = 512; g.ksplit = 512; g.Bt = W + OFF_POOL + i * SZ_POOL; g.K = 512;
        g.ntn = 4; g.mtiles = ctx_later ? 272 : 256; g.C = YP; g.ldc = 512;
        [[fallthrough]];
      case T_GEMM_BF16: gemm_phase<4, EPI_BF16>(g, smem); break;
      case T_SCAN:
        scan_phase(p, i, Rr, Kk, Vv, LO, LO + (size_t)MT * 512, LO + (size_t)2 * MT * 512, LO + (size_t)3 * MT * 512, Y0, Y1, smem);
        break;
      case T_MERGE:
        merge_phase(p, i, ctx_later ? MT : ML, Rr, Kk, Vv, LO + (size_t)2 * MT * 512, LO + (size_t)3 * MT * 512,
                    LO + (size_t)4 * MT * 512, Y0, Y1);
        break;
      case T_FFN: gemm_phase<4, EPI_FFN>(g, smem); break;
      case T_ODD: gemm_phase<3, EPI_ODD>(g, smem); break;
    }
    if (coop && ph + 1 < ph_hi) grid.sync();
  }
}

extern "C" void kernel_launch(void* const* d_in, const int* in_sizes, int n_in, void* d_out, int out_size, void* d_ws,
                              size_t ws_size, hipStream_t stream) {
  Params p{};
  const float** pp = (const float**)&p;
  for (int k = 0; k < 28; ++k) pp[k] = (const float*)d_in[k];
  p.out = (float*)d_out;
  p.ws = (char*)d_ws;
  static int grid_blocks = 0;
  if (!grid_blocks) {
    int dev = 0, cus = 0, per_cu = 0;
    (void)hipGetDevice(&dev);
    (void)hipDeviceGetAttribute(&cus, hipDeviceAttributeMultiprocessorCount, dev);
    (void)hipOccupancyMaxActiveBlocksPerMultiprocessor(&per_cu, mega, 256, 0);
    if (per_cu > 2) per_cu = 2;
    if (per_cu < 1) per_cu = 1;
    grid_blocks = cus * per_cu;
    grid_blocks -= grid_blocks % 8;
  }
#if COOP
  int lo = 0, hi = NPHASES, coop = 1;
  void* args[] = {&p, &lo, &hi, &coop};
  hipError_t e = hipLaunchCooperativeKernel((void*)mega, dim3(grid_blocks), dim3(256), args, 0, stream);
  if (e != hipSuccess) fprintf(stderr, "cooperative launch failed: %s (grid %d)\n", hipGetErrorString(e), grid_blocks);
#else
  for (int ph = 0; ph < NPHASES; ++ph) hipLaunchKernelGGL(mega, dim3(grid_blocks), dim3(256), 0, stream, p, ph, ph + 1, 0);
#endif
}
```

```cpp
#include <hip/hip_runtime.h>
#include <hip/hip_bf16.h>
#include <hip/hip_cooperative_groups.h>
#include <cstdio>
namespace cg = cooperative_groups;

typedef unsigned short u16;
typedef _Float16 h16;
using bf16x8 = __attribute__((ext_vector_type(8))) short;
using f32x4 = __attribute__((ext_vector_type(4))) float;
typedef float f2 __attribute__((ext_vector_type(2)));
using h16x4 = __attribute__((ext_vector_type(4))) _Float16;
using u16x4 = __attribute__((ext_vector_type(4))) unsigned short;
using u16x8 = __attribute__((ext_vector_type(8))) unsigned short;

#ifndef REP_MASK
#define REP_MASK 0
#endif
#ifndef COOP
#define COOP 1
#endif

constexpr int D = 1024, NB = 8, SEQ = 4096, CTX = 256, DEPTH = 4;
constexpr int ML = NB * SEQ;
constexpr int MC = NB * CTX;
constexpr int MT = ML + MC;
constexpr int DFF = 2816;
constexpr int NEV = 2336, NEVP = 2560, DPROJ = 1824;
constexpr int NTHR = 512, NWV = 8;
constexpr int LORA_K = 384, LORA_N = 2560;
constexpr float RMS_EPS = 1e-6f, GN_EPS = 64e-5f;

constexpr size_t SZ_FFNUP = 5632ull * 1024, SZ_FFNDN = 1024ull * 2816, SZ_EVIN = 2560ull * 1024, SZ_SQ = 1024ull * 1024,
                 SZ_LORA = 2560ull * 384, SZ_POOL = 512ull * 512, SZ_ODIN = 3072ull * 1024;
constexpr size_t OFF_FFNUP = 0;
constexpr size_t OFF_FFNDN = OFF_FFNUP + 4 * SZ_FFNUP;
constexpr size_t OFF_EVIN = OFF_FFNDN + 4 * SZ_FFNDN;
constexpr size_t OFF_EVOUT = OFF_EVIN + 2 * SZ_EVIN;
constexpr size_t OFF_LORA = OFF_EVOUT + 2 * SZ_SQ;
constexpr size_t OFF_POOL = OFF_LORA + 2 * SZ_LORA;
constexpr size_t OFF_ODIN = OFF_POOL + 2 * SZ_POOL;
constexpr size_t OFF_ODOUT = OFF_ODIN + 2 * SZ_ODIN;
constexpr size_t W_ELEMS = OFF_ODOUT + 2 * SZ_SQ;
constexpr size_t B_MOD = W_ELEMS * 2;
constexpr size_t B_XC = B_MOD + 4ull * 9 * 6144 * 4;
constexpr size_t B_KINV = B_XC + (size_t)MC * D * 4;
constexpr size_t B_ACT = B_KINV + (size_t)MT * 8 * 4;
constexpr size_t UU = (size_t)MT * 512 * 2;
#define ACT(p, u) ((p).ws + B_ACT + (size_t)(u) * UU)

struct Params {
  const float *x, *c, *ctx, *c_ctx, *w_mod, *b_mod, *norm_g, *ffn_w_up, *ffn_conv, *ffn_w_down,
      *ev_w_in, *ev_w_out, *ev_mu, *ev_w0, *ev_w_up, *ev_a0, *ev_a_up, *ev_g_up, *ev_k_k, *ev_k_a, *ev_r_k,
      *ev_gn_w, *ev_gn_b, *ev_pool_w, *ev_pool_scale, *od_w_in, *od_conv, *od_w_out;
  float* out;
  char* ws;
};

__device__ __forceinline__ u16 f2bf(float f) {
  unsigned u = __float_as_uint(f);
  u += 0x7fffu + ((u >> 16) & 1u);
  return (u16)(u >> 16);
}
__device__ __forceinline__ float bf2f(u16 h) { return __uint_as_float(((unsigned)h) << 16); }
__device__ __forceinline__ float sigmoidf_(float x) { return 1.f / (1.f + __expf(-x)); }
__device__ __forceinline__ float siluf_(float x) { return x / (1.f + __expf(-x)); }

template <int CTRL>
__device__ __forceinline__ float dppf(float x) {
  return __builtin_bit_cast(float, __builtin_amdgcn_update_dpp(0, __builtin_bit_cast(int, x), CTRL, 0xf, 0xf, true));
}
__device__ __forceinline__ float row16_sum(float x) {
  x += dppf<0x128>(x);
  x += dppf<0x124>(x);
  x += dppf<0x122>(x);
  x += dppf<0x121>(x);
  return x;
}
__device__ __forceinline__ float wave_sum(float x) {
  x = row16_sum(x);
  x += __shfl_xor(x, 16);
  x += __shfl_xor(x, 32);
  return x;
}

__device__ __forceinline__ int opaque_tid() { int t = threadIdx.x; asm volatile("" : "+v"(t)); return t; }
__device__ __forceinline__ int opaque_bid() { int t = blockIdx.x; asm volatile("" : "+s"(t)); return t; }
__device__ __forceinline__ int vblock(int bid) { return (bid & 7) * (gridDim.x >> 3) + (bid >> 3); }

__device__ __forceinline__ int map_col(int kind, int nd, int srcN) {
  if (kind == 0) return nd < srcN ? nd : -1;
  if (kind == 1) {
    int t = nd >> 7, r = nd & 127, wc = r >> 6, half = (r >> 5) & 1, j = r & 31;
    return half * DFF + t * 64 + wc * 32 + j;
  }
  int t = nd / 96, r = nd % 96, wc = r / 48, part = (r % 48) >> 4, j = r & 15;
  return part * 1024 + t * 32 + wc * 16 + j;
}

__device__ void conv_tile(const float* __restrict__ src, int srcN, int K, u16* __restrict__ dst, int kind, int tile,
                          int ntn64, float* sT) {
  const int TIDX = opaque_tid(); const int BIDX = opaque_bid(); (void)TIDX; (void)BIDX;
  int tn = tile % ntn64, tk = tile / ntn64;
  int n0 = tn * 64, k0 = tk * 64;
  int tx = TIDX & 63, ty = TIDX >> 6;
  int sc = map_col(kind, n0 + tx, srcN);
#pragma unroll
  for (int kk = ty; kk < 64; kk += 8) {
    float v = sc >= 0 ? src[(size_t)(k0 + kk) * srcN + sc] : 0.f;
    sT[kk * 65 + tx] = v;
  }
  __syncthreads();
  int n = TIDX >> 3, kq = (TIDX & 7) * 8;
  u16x8 o0;
#pragma unroll
  for (int e = 0; e < 8; ++e) o0[e] = f2bf(sT[(kq + e) * 65 + n]);
  u16* d = dst + (size_t)(n0 + n) * K + k0 + kq;
  *(u16x8*)d = o0;
  __syncthreads();
}

__device__ __forceinline__ void pre_phase(const Params& p, char* smem) {
  const int TIDX = opaque_tid(); const int BIDX = opaque_bid(); (void)TIDX; (void)BIDX;
  u16* W = (u16*)p.ws;
  float* sT = (float*)smem;
  constexpr int T_UP = 88 * 16, T_DN = 16 * 44, T_EVIN = 40 * 16, T_SQ = 256, T_ODIN = 48 * 16;
  constexpr int N_BIG = 4 * T_UP + 4 * T_DN + 2 * (T_EVIN + T_SQ + T_ODIN + T_SQ);
  constexpr int N_LORA = 240, N_POOL = 64;
  constexpr int N_SMALL = 2 * (N_LORA + N_POOL);
  constexpr int N_MOD = 4 * 96;
  constexpr int N_ALL = N_BIG + N_SMALL + N_MOD;
  for (int it = BIDX; it < N_ALL; it += gridDim.x) {
    if (it < N_MOD) {
      int l = it / 96, c0 = (it % 96) * 64;
      float* sS = (float*)smem;
      float* sR = sS + 9 * 1024;
      for (int e = TIDX; e < 9 * 1024; e += NTHR) {
        int j = e >> 10, k = e & 1023;
        float cv = j < 8 ? p.c[j * 1024 + k] : p.c_ctx[k];
        sS[e] = siluf_(cv);
      }
      __syncthreads();
      int w = TIDX >> 6, lane = TIDX & 63;
      float acc[9];
#pragma unroll
      for (int j = 0; j < 9; ++j) acc[j] = 0.f;
      const float* wm = p.w_mod + (size_t)l * 1024 * 6144 + c0 + lane;
#pragma unroll 8
      for (int k = w * 128; k < w * 128 + 128; ++k) {
        float wv = wm[(size_t)k * 6144];
#pragma unroll
        for (int j = 0; j < 9; ++j) acc[j] += sS[j * 1024 + k] * wv;
      }
#pragma unroll
      for (int j = 0; j < 9; ++j) sR[(w * 9 + j) * 64 + lane] = acc[j];
      __syncthreads();
      for (int e = TIDX; e < 9 * 64; e += NTHR) {
        int j = e >> 6, cc = e & 63;
        float s = 0.f;
#pragma unroll
        for (int ww = 0; ww < 8; ++ww) s += sR[(ww * 9 + j) * 64 + cc];
        s += p.b_mod[l * 6144 + c0 + cc];
        ((float*)(p.ws + B_MOD))[(size_t)(l * 9 + j) * 6144 + c0 + cc] = s;
      }
      __syncthreads();
      continue;
    }
    int t = it - N_MOD;
    if (t < N_BIG) {
      if (t < 4 * T_UP) {
        int l = t / T_UP;
        conv_tile(p.ffn_w_up + (size_t)l * 1024 * 5632, 5632, 1024, W + OFF_FFNUP + l * SZ_FFNUP, 1, t % T_UP, 88, sT);
        continue;
      }
      t -= 4 * T_UP;
      if (t < 4 * T_DN) {
        int l = t / T_DN;
        conv_tile(p.ffn_w_down + (size_t)l * 2816 * 1024, 1024, 2816, W + OFF_FFNDN + l * SZ_FFNDN, 0, t % T_DN, 16, sT);
        continue;
      }
      t -= 4 * T_DN;
      if (t < 2 * T_EVIN) {
        int i = t / T_EVIN;
        conv_tile(p.ev_w_in + (size_t)i * 1024 * NEV, NEV, 1024, W + OFF_EVIN + i * SZ_EVIN, 0, t % T_EVIN, 40, sT);
        continue;
      }
      t -= 2 * T_EVIN;
      if (t < 2 * T_SQ) {
        int i = t / T_SQ;
        conv_tile(p.ev_w_out + (size_t)i * SZ_SQ, 1024, 1024, W + OFF_EVOUT + i * SZ_SQ, 0, t % T_SQ, 16, sT);
        continue;
      }
      t -= 2 * T_SQ;
      if (t < 2 * T_ODIN) {
        int i = t / T_ODIN;
        conv_tile(p.od_w_in + (size_t)i * 1024 * 3072, 3072, 1024, W + OFF_ODIN + i * SZ_ODIN, 2, t % T_ODIN, 48, sT);
        continue;
      }
      t -= 2 * T_ODIN;
      {
        int i = t / T_SQ;
        conv_tile(p.od_w_out + (size_t)i * SZ_SQ, 1024, 1024, W + OFF_ODOUT + i * SZ_SQ, 0, t % T_SQ, 16, sT);
        continue;
      }
    }
    t -= N_BIG;
    {
      int i = t / (N_LORA + N_POOL);
      int r = t % (N_LORA + N_POOL);
      if (r < N_LORA) {
        u16* dst = W + OFF_LORA + i * SZ_LORA;
        for (int e = r * 4096 + TIDX; e < r * 4096 + 4096; e += NTHR) {
          int n = e / LORA_K, k = e % LORA_K;
          int seg = n >> 9, cc = n & 511;
          float v = 0.f;
          if (seg == 0) { if (k < 32) v = p.ev_w_up[((size_t)(i * 2 + 0) * 32 + k) * 512 + cc]; }
          else if (seg == 1) { if (k >= 32 && k < 64) v = p.ev_w_up[((size_t)(i * 2 + 1) * 32 + (k - 32)) * 512 + cc]; }
          else if (seg == 2) { if (k >= 64 && k < 128) v = p.ev_a_up[((size_t)(i * 2 + 0) * 64 + (k - 64)) * 512 + cc]; }
          else if (seg == 3) { if (k >= 128 && k < 192) v = p.ev_a_up[((size_t)(i * 2 + 1) * 64 + (k - 128)) * 512 + cc]; }
          else { if (k >= 192 && k < 288) v = p.ev_g_up[((size_t)i * 96 + (k - 192)) * 512 + cc]; }
          dst[e] = f2bf(v);
        }
      } else {
        r -= N_LORA;
        u16* dst = W + OFF_POOL + i * SZ_POOL;
        for (int e = r * 4096 + TIDX; e < r * 4096 + 4096; e += NTHR) {
          int n = e >> 9, k = e & 511;
          float v = 0.f;
          int g = n >> 7;
          if ((k >> 7) == g) v = p.ev_pool_w[(((size_t)i * 4 + g) * 128 + (k & 127)) * 128 + (n & 127)] * p.ev_pool_scale[i * 512 + n];
          dst[e] = f2bf(v);
        }
      }
    }
  }
}

__device__ __forceinline__ void row_phase(const Params& p, const bool HAS_Y, const bool HAS_H, int nrows, const u16* __restrict__ Y,
                          const float* __restrict__ modg  , int gate_chunk, const float* __restrict__ gy,
                          const float* __restrict__ gx, const float* __restrict__ modh  , int shift_chunk,
                          u16* __restrict__ H) {
  const int TIDX = opaque_tid(); const int BIDX = opaque_bid();
  const int lane = TIDX & 63;
  const int gw = BIDX * NWV + (TIDX >> 6), nw = gridDim.x * NWV;
  const int rpw = (nrows + nw - 1) / nw;
  const int r_begin = gw * rpw, r_end = min(r_begin + rpw, nrows);
  float* XC = (float*)(p.ws + B_XC);
  float4 gyv[4], gxv[4], gtv[4], shv[4], scv[4];
#pragma unroll
  for (int i = 0; i < 4; ++i) {
    gyv[i] = HAS_Y ? *(const float4*)(gy + i * 256 + lane * 4) : float4{0.f, 0.f, 0.f, 0.f};
    gxv[i] = HAS_H ? *(const float4*)(gx + i * 256 + lane * 4) : float4{0.f, 0.f, 0.f, 0.f};
    gtv[i] = shv[i] = scv[i] = float4{0.f, 0.f, 0.f, 0.f};
  }
  int bcur = -1;
#pragma unroll 1
  for (int row = r_begin; row < r_end; ++row) {
    const int b = row < ML ? (row >> 12) : 8;
    if (b != bcur) {
      bcur = b;
#pragma unroll
      for (int i = 0; i < 4; ++i) {
        const int c = i * 256 + lane * 4;
        if (HAS_Y) gtv[i] = *(const float4*)(modg + (size_t)b * 6144 + gate_chunk * 1024 + c);
        if (HAS_H) {
          shv[i] = *(const float4*)(modh + (size_t)b * 6144 + shift_chunk * 1024 + c);
          scv[i] = *(const float4*)(modh + (size_t)b * 6144 + (shift_chunk + 1) * 1024 + c);
        }
      }
    }
    float* xr = row < ML ? p.out + (size_t)row * D : XC + (size_t)(row - ML) * D;
    float4 xv[4];
    if (HAS_Y) {
#pragma unroll
      for (int i = 0; i < 4; ++i) xv[i] = *(const float4*)(xr + i * 256 + lane * 4);
      float yv[16];
      float ss = 0.f;
#pragma unroll
      for (int i = 0; i < 4; ++i) {
        u16x4 t = *(const u16x4*)(Y + (size_t)row * D + i * 256 + lane * 4);
#pragma unroll
        for (int e = 0; e < 4; ++e) { yv[i * 4 + e] = bf2f(t[e]); ss += yv[i * 4 + e] * yv[i * 4 + e]; }
      }
      ss = wave_sum(ss);
      float rstd = rsqrtf(ss * (1.f / D) + RMS_EPS);
#pragma unroll
      for (int i = 0; i < 4; ++i) {
        xv[i].x += gtv[i].x * (yv[i * 4 + 0] * rstd * gyv[i].x);
        xv[i].y += gtv[i].y * (yv[i * 4 + 1] * rstd * gyv[i].y);
        xv[i].z += gtv[i].z * (yv[i * 4 + 2] * rstd * gyv[i].z);
        xv[i].w += gtv[i].w * (yv[i * 4 + 3] * rstd * gyv[i].w);
      }
    } else {
      const float* src = row < ML ? p.x + (size_t)row * D : p.ctx + (size_t)(row - ML) * D;
#pragma unroll
      for (int i = 0; i < 4; ++i) xv[i] = *(const float4*)(src + i * 256 + lane * 4);
    }
#pragma unroll
    for (int i = 0; i < 4; ++i) *(float4*)(xr + i * 256 + lane * 4) = xv[i];
    if (HAS_H) {
      float ss = 0.f;
#pragma unroll
      for (int i = 0; i < 4; ++i) ss += xv[i].x * xv[i].x + xv[i].y * xv[i].y + xv[i].z * xv[i].z + xv[i].w * xv[i].w;
      ss = wave_sum(ss);
      float rstd = rsqrtf(ss * (1.f / D) + RMS_EPS);
#pragma unroll
      for (int i = 0; i < 4; ++i) {
        u16x4 o;
        o[0] = f2bf(xv[i].x * rstd * gxv[i].x * (1.f + scv[i].x) + shv[i].x);
        o[1] = f2bf(xv[i].y * rstd * gxv[i].y * (1.f + scv[i].y) + shv[i].y);
        o[2] = f2bf(xv[i].z * rstd * gxv[i].z * (1.f + scv[i].z) + shv[i].z);
        o[3] = f2bf(xv[i].w * rstd * gxv[i].w * (1.f + scv[i].w) + shv[i].w);
        *(u16x4*)(H + (size_t)row * D + i * 256 + lane * 4) = o;
      }
    }
  }
}

enum { EPI_BF16 = 0, EPI_FFN = 1, EPI_ODD = 2, EPI_LORA = 3 };

struct GemmP {
  const u16* A1; const u16* A2; int lda1, lda2, ksplit;
  const u16* Bt; int K; int ntn; int mtiles; int conv;
  u16* C; int ldc;
  const float* cw;
  int cwC;
  const float* w0; const float* a0; h16* lout;
};

__device__ __forceinline__ bool seg_start(int a) { return a < ML ? ((a & 63) == 0) : (((a - ML) & 255) == 0); }
__device__ __forceinline__ bool seg_end(int a) { return a < ML ? ((a & 63) == 63) : (((a - ML) & 255) == 255); }

#define RAW_BARRIER() do { asm volatile("s_waitcnt lgkmcnt(0)" ::: "memory"); __builtin_amdgcn_s_barrier(); } while (0)
constexpr int GSTAGE = 65536;
constexpr int NSTG = 2;
constexpr int SMEM_BYTES = NSTG * GSTAGE;

template <int NT, int EPI>
__device__ __forceinline__ void gemm_phase(const GemmP& g, char* smem) {
  const int TIDX = opaque_tid(); const int BIDX = opaque_bid(); (void)TIDX; (void)BIDX;
  constexpr int BN = 64 * NT;
  const int tid = TIDX, wid = tid >> 6, lane = tid & 63, wr = wid >> 2, wc = wid & 3, fr = lane & 15, fq = lane >> 4;
  const int ntiles = g.mtiles * g.ntn;
  const int sr = tid >> 3;
  const int scol = ((tid & 7) ^ ((sr >> 1) & 7)) * 8;
  const int sw0 = ((fq) ^ (fr >> 1)) * 8, sw1 = ((4 + fq) ^ (fr >> 1)) * 8;
#pragma unroll 1
  for (int tile = vblock(BIDX); tile < ntiles; tile += gridDim.x) {
    int grp_ = tile / (8 * g.ntn), rem_ = tile - grp_ * 8 * g.ntn;
    int nt = rem_ >> 3, mt = grp_ * 8 + (rem_ & 7);
    const int row0 = mt * 256;
    const int n0 = nt * BN;
    f32x4 acc[8][NT];
#pragma unroll
    for (int m = 0; m < 8; ++m)
#pragma unroll
      for (int n = 0; n < NT; ++n) acc[m][n] = f32x4{0.f, 0.f, 0.f, 0.f};
    const int nk = g.K >> 6;
    const u16* bbase = g.Bt + (size_t)(n0 + sr) * g.K + scol;
    auto piece = [&](int t, int st, int q) {
      char* base = smem + st * GSTAGE + tid * 16;
      int kk = t << 6;
      if (q < 4) {
        const u16* Ab; int lda;
        if (kk < g.ksplit) { Ab = g.A1 + kk; lda = g.lda1; } else { Ab = g.A2 + (kk - g.ksplit); lda = g.lda2; }
        const u16* ap = Ab + (size_t)(row0 + sr + 64 * q) * lda + scol;
        __builtin_amdgcn_global_load_lds((const unsigned*)(ap), (unsigned*)(base + q * 8192), 16, 0, 0);
      } else {
        const int qq = (NT == 3 && q == 7) ? 2 : q - 4;
        __builtin_amdgcn_global_load_lds((const unsigned*)(bbase + (size_t)(64 * qq) * g.K + kk), (unsigned*)(base + 32768 + (q - 4) * 8192), 16, 0, 0);
      }
    };
    auto issue = [&](int t, int st) {
#pragma unroll
      for (int q = 0; q < 8; ++q) piece(t, st, q);
    };
    issue(0, 0);
#pragma unroll 1
    for (int t = 0; t < nk; ++t) {
      const int st = t & 1;
      asm volatile("s_waitcnt vmcnt(0)" ::: "memory");
      RAW_BARRIER();
      const bool more = t + 1 < nk;
      const u16* SA = (const u16*)(smem + st * GSTAGE);
      const u16* SB = (const u16*)(smem + st * GSTAGE + 32768);
#pragma unroll
      for (int ks = 0; ks < 2; ++ks) {
        const int sw = ks ? sw1 : sw0;
        bf16x8 Bf[NT];
#pragma unroll
        for (int n = 0; n < NT; ++n) Bf[n] = *(const bf16x8*)(SB + (wc * 16 * NT + n * 16 + fr) * 64 + sw);
#pragma unroll
        for (int mh = 0; mh < 2; ++mh) {
          bf16x8 At[4];
#pragma unroll
          for (int m = 0; m < 4; ++m) At[m] = *(const bf16x8*)(SA + (wr * 128 + mh * 64 + m * 16 + fr) * 64 + sw);
#pragma unroll
          for (int m = 0; m < 4; ++m) {
#pragma unroll
            for (int n = 0; n < NT; ++n)
              acc[mh * 4 + m][n] = __builtin_amdgcn_mfma_f32_16x16x32_bf16(At[m], Bf[n], acc[mh * 4 + m][n], 0, 0, 0);
            if (ks == 0) {
              if (more) piece(t + 1, st ^ 1, mh * 4 + m);
            }
          }
        }
      }
    }
    __syncthreads();
    if (EPI == EPI_BF16) {
#pragma unroll
      for (int m = 0; m < 8; ++m)
#pragma unroll
        for (int j = 0; j < 4; ++j) {
          int r = wr * 128 + m * 16 + fq * 4 + j;
          size_t ro = (size_t)(row0 + r) * g.ldc + n0 + wc * 16 * NT + fr;
#pragma unroll
          for (int n = 0; n < NT; ++n) g.C[ro + n * 16] = f2bf(acc[m][n][j]);
        }
    } else if (EPI == EPI_LORA) {
      const int seg = n0 >> 9;
      h16* dst = g.lout + (size_t)seg * MT * 512 + (size_t)row0 * 512 + (n0 & 511) + wc * 16 * NT + fr;
      float bias[NT];
#pragma unroll
      for (int n = 0; n < NT; ++n) {
        int cc = (n0 & 511) + wc * 16 * NT + n * 16 + fr;
        bias[n] = seg < 2 ? g.w0[seg * 512 + cc] : (seg < 4 ? g.a0[(seg - 2) * 512 + cc] : 0.f);
      }
      auto lora_store = [&](auto fn) {
        unsigned ro = (unsigned)(wr * 128 + fq * 4) * 512;
#pragma unroll
        for (int m = 0; m < 8; ++m) {
          asm volatile("" : "+v"(ro));
#pragma unroll
          for (int n = 0; n < NT; ++n)
#pragma unroll
            for (int j = 0; j < 4; ++j)
              dst[ro + j * 512 + n * 16] = (h16)fn(acc[m][n][j] + bias[n]);
          ro += 16 * 512;
          __syncthreads();
        }
      };
      if (seg < 2) {
        lora_store([](float v) { float sp = -v > 20.f ? -v : __logf(1.f + __expf(-v)); return -__expf(-sp - 0.5f); });
      } else if (seg < 4) {
        lora_store([](float v) { return sigmoidf_(v); });
      } else {
        lora_store([](float v) { return v; });
      }
    } else {
      constexpr int CW = (EPI == EPI_FFN) ? 128 : 64;
      constexpr int CPW = CW / 4;
      constexpr int NA = CPW / 16;
      float* sC = (float*)smem;
      constexpr int LDC = (EPI == EPI_FFN) ? DFF : D;
      const int colofs = wc * CPW + fr;
      {
        float* sb = sC + (wr * 128 + fq * 4) * CW + colofs;
#pragma unroll
        for (int m = 0; m < 8; ++m)
#pragma unroll
          for (int n = 0; n < NA; ++n)
#pragma unroll
            for (int j = 0; j < 4; j += 3) {
              float u = (EPI == EPI_FFN) ? acc[m][n][j] : acc[m][1][j] * acc[m][2][j];
              sb[(m * 16 + j) * CW + n * 16] = u;
            }
      }
      __syncthreads();
      float cwv[NA][3];
#pragma unroll
      for (int n = 0; n < NA; ++n) {
        int ch = nt * CW + colofs + n * 16;
        cwv[n][0] = g.cw[ch]; cwv[n][1] = g.cw[g.cwC + ch]; cwv[n][2] = g.cw[2 * g.cwC + ch];
      }
      const bool lat = row0 < ML;
      const int segmask = lat ? 63 : 255;
      u16* const cbase = g.C + (size_t)row0 * LDC + nt * CW + colofs;
      int rb = wr * 128 + fq * 4;
#pragma unroll
      for (int m = 0; m < 8; ++m) {
        asm volatile("" : "+v"(rb));
        const int so = rb * CW + colofs;
        const unsigned co = (unsigned)rb * LDC;
#pragma unroll
        for (int n = 0; n < NA; ++n) {
          float c4[4];
#pragma unroll
          for (int j = 0; j < 4; ++j) c4[j] = (EPI == EPI_FFN) ? acc[m][n][j] : acc[m][1][j] * acc[m][2][j];
          const float pv0 = sC[max(so - CW, 0) + n * 16];
          const float nv3 = sC[min(so + 4 * CW, 255 * CW + colofs) + n * 16];
#pragma unroll
          for (int j = 0; j < 4; ++j) {
            const int r = rb + j;
            float pv = (j == 0) ? pv0 : c4[j - 1];
            float nv = (j == 3) ? nv3 : c4[j + 1];
            pv = ((r & segmask) == 0) ? 0.f : pv;
            nv = ((r & segmask) == segmask) ? 0.f : nv;
            const float cv = cwv[n][0] * pv + cwv[n][1] * c4[j] + cwv[n][2] * nv;
            const float o = (EPI == EPI_FFN) ? siluf_(cv) * acc[m][n + 2][j] : acc[m][0][j] * cv;
            cbase[co + j * LDC + n * 16] = f2bf(o);
          }
        }
        rb += 16;
        __syncthreads();
      }
      __syncthreads();
    }
  }
}

using f16x8 = __attribute__((ext_vector_type(8))) _Float16;
__device__ __forceinline__ void prep1_phase(const Params& p, int i, int nrows, const u16* __restrict__ P, h16* __restrict__ R,
                                            h16* __restrict__ Kk, h16* __restrict__ V, u16* __restrict__ L, u16* __restrict__ Dp) {
  const int TIDX = opaque_tid(); const int BIDX = opaque_bid();
  const int lane = TIDX & 63;
  const int gw = BIDX * NWV + (TIDX >> 6), nw = gridDim.x * NWV;
  const float* mu0 = p.ev_mu + (size_t)i * 2 * DPROJ;
  const float* mu1 = mu0 + DPROJ;
  float* KINV = (float*)(p.ws + B_KINV);
  float m0[3][8], m1[3][8], kkp[8], lm0[8], lm1[8];
#pragma unroll
  for (int q = 0; q < 3; ++q)
#pragma unroll
    for (int e = 0; e < 8; ++e) { int c = (lane + 64 * q) * 8 + e; m0[q][e] = mu0[c]; m1[q][e] = mu1[c]; }
#pragma unroll
  for (int e = 0; e < 8; ++e) kkp[e] = p.ev_k_k[i * 512 + lane * 8 + e];
  const int ll = lane < 36 ? lane : 35;
#pragma unroll
  for (int e = 0; e < 8; ++e) { lm0[e] = mu0[1536 + ll * 8 + e]; lm1[e] = mu1[1536 + ll * 8 + e]; }
  const int gi = lane >> 4, half = 1 << gi;
  const u16x8 zero8 = {0, 0, 0, 0, 0, 0, 0, 0};
#pragma unroll 1
  for (int row = gw; row < nrows; row += nw) {
    const bool lat = row < ML;
    const int t = lat ? (row & 4095) : ((row - ML) & 255);
    const int tl = lat ? 4095 : 255;
    const bool hp = t > 0, hn = t < tl;
    const u16* pc = P + (size_t)row * NEVP;
    const u16* pp = hp ? pc - NEVP : pc;
    const u16* pn = hn ? pc + NEVP : pc;
    u16x8 cur[3], pv[3], nv[3];
#pragma unroll
    for (int q = 0; q < 3; ++q) {
      int c = (lane + 64 * q) * 8;
      cur[q] = *(const u16x8*)(pc + c); pv[q] = *(const u16x8*)(pp + c); nv[q] = *(const u16x8*)(pn + c);
    }
    u16x8 lc = *(const u16x8*)(pc + 1536 + ll * 8), lp = *(const u16x8*)(pp + 1536 + ll * 8), ln = *(const u16x8*)(pn + 1536 + ll * 8);
    const int pos = lat ? (row & 63) : ((row - ML) & 255);
    const int Lr = lat ? 64 : 256;
    u16x8 pw[16];
#pragma unroll
    for (int dd = 0; dd < 16; ++dd) {
      int jj = min(max(pos + dd - 8, 0), Lr - 1);
      pw[dd] = *(const u16x8*)(pc + (ptrdiff_t)(jj - pos) * NEVP + DPROJ + lane * 8);
    }
    float ssq = 0.f;
#pragma unroll
    for (int q = 0; q < 3; ++q) {
      f16x8 o;
#pragma unroll
      for (int e = 0; e < 8; ++e) {
        float c = bf2f(cur[q][e]);
        float a = hp ? bf2f(pv[q][e]) : 0.f;
        float n = hn ? bf2f(nv[q][e]) : 0.f;
        float sv = c + m0[q][e] * (a - c) + m1[q][e] * (n - c);
        o[e] = (h16)sv;
        if (q == 1) { float kr = sv * kkp[e]; ssq += kr * kr; }
      }
      h16* dst = q == 0 ? R : (q == 1 ? Kk : V);
      *(f16x8*)(dst + (size_t)row * 512 + lane * 8) = o;
    }
    ssq += __shfl_xor(ssq, 1);
    ssq += __shfl_xor(ssq, 2);
    ssq += __shfl_xor(ssq, 4);
    if ((lane & 7) == 0) KINV[(size_t)row * 8 + (lane >> 3)] = rsqrtf(fmaxf(ssq, 1e-24f));
    if (lane < 48) {
      u16x8 o = zero8;
      if (lane < 36) {
#pragma unroll
        for (int e = 0; e < 8; ++e) {
          float c = bf2f(lc[e]);
          float a = hp ? bf2f(lp[e]) : 0.f;
          float n = hn ? bf2f(ln[e]) : 0.f;
          float sv = c + lm0[e] * (a - c) + lm1[e] * (n - c);
          float ov = lane < 8 ? tanhf(sv) : (lane < 24 ? sv : sigmoidf_(sv));
          o[e] = f2bf(ov);
        }
      }
      *(u16x8*)(L + (size_t)row * LORA_K + lane * 8) = o;
    }
    {
      float sum[8];
#pragma unroll
      for (int e = 0; e < 8; ++e) sum[e] = 0.f;
#pragma unroll
      for (int dd = 0; dd < 16; ++dd) {
        int d = dd - 8, jj = pos + d;
        bool ok = d >= -half && d < half && jj >= 0 && jj < Lr;
        float mk = ok ? 1.f : 0.f;
#pragma unroll
        for (int e = 0; e < 8; ++e) sum[e] += mk * bf2f(pw[dd][e]);
      }
      int lo = max(pos - half, 0), hi = min(pos + half, Lr);
      float inv = 1.f / (float)(hi - lo);
      u16x8 o;
#pragma unroll
      for (int e = 0; e < 8; ++e) o[e] = f2bf(sum[e] * inv - bf2f(pw[8][e]));
      *(u16x8*)(Dp + (size_t)row * 512 + lane * 8) = o;
    }
  }
}

__device__ __forceinline__ void scan_phase(const Params& p, int i, const h16* __restrict__ R, const h16* __restrict__ Kk,
                                           const h16* __restrict__ V, const h16* __restrict__ W0, const h16* __restrict__ W1,
                                           const h16* __restrict__ A0, const h16* __restrict__ A1, u16* __restrict__ Y0,
                                           u16* __restrict__ Y1, char* smem) {
  const int TIDX = opaque_tid(); const int BIDX = opaque_bid();
  const int tid = TIDX, wid = tid >> 6, lane = tid & 63;
  const int grp = lane >> 4, j16 = lane & 15;
  const float* KINV = (const float*)(p.ws + B_KINV);
  float* sOp = (float*)smem;
  const bool stager = tid >= 256;
  const int stid = tid & 255;
#pragma unroll 1
  for (int item = BIDX; item < 256; item += gridDim.x) {
    int half = item & 1, dir = (item >> 1) & 1, h = (item >> 2) & 7, b = item >> 5;
    const h16* Wd = dir ? W1 : W0;
    const h16* Ad = dir ? A1 : A0;
    u16* Yd = dir ? Y1 : Y0;
    int ss = stid >> 4, c4 = (stid & 15) * 4;
    float kkp[4], kap[4];
#pragma unroll
    for (int e = 0; e < 4; ++e) { kkp[e] = p.ev_k_k[i * 512 + h * 64 + c4 + e]; kap[e] = p.ev_k_a[i * 512 + h * 64 + c4 + e]; }
    const int rowA = half * 32 + (wid & 3) * 8 + grp * 2;
    f2 S0a = {0.f, 0.f}, S0b = {0.f, 0.f}, S1a = {0.f, 0.f}, S1b = {0.f, 0.f};

    auto tok_row = [&](int cidx, int s) -> int {
      if (cidx < 16) { int q = cidx * 16 + s; int tk = dir ? 255 - q : q; return ML + b * 256 + tk; }
      int q = (cidx - 16) * 16 + s; int tk = dir ? 4095 - q : q; return b * 4096 + tk;
    };
    h16x4 lr, lk, lv, lw, la; float linv;
    auto gload = [&](int cidx) {
      size_t o = (size_t)tok_row(cidx, ss) * 512 + h * 64 + c4;
      lr = *(const h16x4*)(R + o); lk = *(const h16x4*)(Kk + o); lv = *(const h16x4*)(V + o);
      lw = *(const h16x4*)(Wd + o); la = *(const h16x4*)(Ad + o);
      linv = KINV[(size_t)tok_row(cidx, ss) * 8 + h];
    };
    auto lstore = [&](int buf) {
      float* base = sOp + (size_t)buf * 16 * 6 * 64 + ss * 6 * 64 + c4;
      float4 kk4, w4, b4, kd4, r4, v4;
      float* kkf = (float*)&kk4; float* wf = (float*)&w4; float* bfp = (float*)&b4; float* kdf = (float*)&kd4;
      float* rf = (float*)&r4; float* vf = (float*)&v4;
#pragma unroll
      for (int e = 0; e < 4; ++e) {
        float k = (float)lk[e], a = (float)la[e];
        float kk = k * kkp[e] * linv;
        kkf[e] = kk;
        wf[e] = __expf((float)lw[e]);
        bfp[e] = kk * a;
        kdf[e] = k * (1.f + (a - 1.f) * kap[e]);
        rf[e] = (float)lr[e];
        vf[e] = (float)lv[e];
      }
      *(float4*)(base + 0 * 64) = kk4; *(float4*)(base + 1 * 64) = w4; *(float4*)(base + 2 * 64) = b4;
      *(float4*)(base + 3 * 64) = kd4; *(float4*)(base + 4 * 64) = r4; *(float4*)(base + 5 * 64) = v4;
    };
    __syncthreads();
    if (stager) { gload(0); lstore(0); }
    __syncthreads();
    constexpr int NCH = 16 + 256;
#pragma unroll 1
    for (int cidx = 0; cidx < NCH; ++cidx) {
      int buf = cidx & 1;
      if (stager) {
        if (cidx + 1 < NCH) { gload(cidx + 1); lstore(buf ^ 1); }
      } else {
        const float* cb = sOp + (size_t)buf * 16 * 6 * 64;
        float yk0 = 0.f, yk1 = 0.f;
        const float* lb = cb + j16 * 4;
        const float* vb = cb + 5 * 64 + rowA;
        float4 c_kk = *(const float4*)(lb + 0 * 64), c_w = *(const float4*)(lb + 1 * 64), c_b = *(const float4*)(lb + 2 * 64),
               c_kd = *(const float4*)(lb + 3 * 64), c_r = *(const float4*)(lb + 4 * 64);
        float2 c_v = *(const float2*)(vb);
#pragma unroll
        for (int s = 0; s < 16; ++s) {
          float4 n_kk, n_w, n_b, n_kd, n_r; float2 n_v;
          if (s < 15) {
            const float* nb = lb + (s + 1) * 6 * 64;
            n_kk = *(const float4*)(nb + 0 * 64); n_w = *(const float4*)(nb + 1 * 64); n_b = *(const float4*)(nb + 2 * 64);
            n_kd = *(const float4*)(nb + 3 * 64); n_r = *(const float4*)(nb + 4 * 64);
            n_v = *(const float2*)(vb + (s + 1) * 6 * 64);
          }
          const f2 kka = {c_kk.x, c_kk.y}, kkb = {c_kk.z, c_kk.w}, wa = {c_w.x, c_w.y}, wb = {c_w.z, c_w.w};
          const f2 ba = {c_b.x, c_b.y}, bb = {c_b.z, c_b.w}, kda = {c_kd.x, c_kd.y}, kdb = {c_kd.z, c_kd.w};
          const f2 ra = {c_r.x, c_r.y}, rb = {c_r.z, c_r.w};
          f2 t0 = __builtin_elementwise_fma(S0b, kkb, S0a * kka);
          f2 t1 = __builtin_elementwise_fma(S1b, kkb, S1a * kka);
          float sa0 = t0.x + t0.y, sa1 = t1.x + t1.y;
          const f2 v0 = {c_v.x, c_v.x}, v1 = {c_v.y, c_v.y};
          f2 u0a = v0 * kda, u0b = v0 * kdb, u1a = v1 * kda, u1b = v1 * kdb;
          sa0 = row16_sum(sa0);
          sa1 = row16_sum(sa1);
          const f2 ns0 = {-sa0, -sa0}, ns1 = {-sa1, -sa1};
          u0a = __builtin_elementwise_fma(ns0, ba, u0a); u0b = __builtin_elementwise_fma(ns0, bb, u0b);
          u1a = __builtin_elementwise_fma(ns1, ba, u1a); u1b = __builtin_elementwise_fma(ns1, bb, u1b);
          S0a = __builtin_elementwise_fma(S0a, wa, u0a); S0b = __builtin_elementwise_fma(S0b, wb, u0b);
          S1a = __builtin_elementwise_fma(S1a, wa, u1a); S1b = __builtin_elementwise_fma(S1b, wb, u1b);
          f2 q0 = __builtin_elementwise_fma(S0b, rb, S0a * ra);
          f2 q1 = __builtin_elementwise_fma(S1b, rb, S1a * ra);
          float y0 = q0.x + q0.y, y1 = q1.x + q1.y;
          y0 = row16_sum(y0);
          y1 = row16_sum(y1);
          if (j16 == s) { yk0 = y0; yk1 = y1; }
          if (s < 15) { c_kk = n_kk; c_w = n_w; c_b = n_b; c_kd = n_kd; c_r = n_r; c_v = n_v; }
        }
        size_t o = (size_t)tok_row(cidx, j16) * 512 + h * 64 + rowA;
        unsigned pk = (unsigned)f2bf(yk0) | ((unsigned)f2bf(yk1) << 16);
        *(unsigned*)(Yd + o) = pk;
      }
      __syncthreads();
    }
  }
}

__device__ __forceinline__ float grp8_sum(float x) {
  x += __shfl_xor(x, 1);
  x += __shfl_xor(x, 2);
  x += __shfl_xor(x, 4);
  return x;
}
__device__ __forceinline__ void merge_phase(const Params& p, int i, int nrows, const h16* __restrict__ R, const h16* __restrict__ Kk,
                                            const h16* __restrict__ V, const h16* __restrict__ A0, const h16* __restrict__ A1,
                                            const h16* __restrict__ Gt, u16* Y0, const u16* __restrict__ Y1) {
  const int TIDX = opaque_tid(); const int BIDX = opaque_bid();
  const int lane = TIDX & 63;
  const int gw = BIDX * NWV + (TIDX >> 6), nw = gridDim.x * NWV;
  float gnw[8], gnb[8], ka[8], rk[8];
#pragma unroll
  for (int e = 0; e < 8; ++e) {
    int c = i * 512 + lane * 8 + e;
    gnw[e] = p.ev_gn_w[c]; gnb[e] = p.ev_gn_b[c]; ka[e] = p.ev_k_a[c]; rk[e] = p.ev_r_k[c];
  }
#pragma unroll 1
  for (int row = gw; row < nrows; row += nw) {
    size_t o = (size_t)row * 512 + lane * 8;
    u16x8 y0 = *(const u16x8*)(Y0 + o), y1 = *(const u16x8*)(Y1 + o);
    f16x8 k8 = *(const f16x8*)(Kk + o), a08 = *(const f16x8*)(A0 + o), a18 = *(const f16x8*)(A1 + o);
    f16x8 r8 = *(const f16x8*)(R + o), v8 = *(const f16x8*)(V + o), g8 = *(const f16x8*)(Gt + o);
    float y[8], s = 0.f, cf = 0.f;
#pragma unroll
    for (int e = 0; e < 8; ++e) {
      y[e] = bf2f(y0[e]) + bf2f(y1[e]);
      s += y[e];
      float kd = (float)k8[e] * (2.f + ((float)a08[e] + (float)a18[e] - 2.f) * ka[e]);
      cf += (float)r8[e] * rk[e] * kd;
    }
    float mean = grp8_sum(s) * (1.f / 64.f);
    cf = grp8_sum(cf);
    float vs = 0.f;
#pragma unroll
    for (int e = 0; e < 8; ++e) { y[e] -= mean; vs += y[e] * y[e]; }
    float rs = rsqrtf(grp8_sum(vs) * (1.f / 64.f) + GN_EPS);
    u16x8 ov;
#pragma unroll
    for (int e = 0; e < 8; ++e) ov[e] = f2bf((y[e] * rs * gnw[e] + gnb[e] + cf * (float)v8[e]) * (float)g8[e]);
    *(u16x8*)(Y0 + o) = ov;
  }
}

constexpr int NPHASES = 34;
enum { T_PRE = 0, T_ROW, T_GEMM_BF16, T_PREP1, T_LORA, T_SCAN, T_MERGE, T_FFN, T_ODD };

__global__ void __launch_bounds__(NTHR, 1) mega(Params p, int ph_lo, int ph_hi, int coop) {
  __shared__ __attribute__((aligned(16))) char smem[SMEM_BYTES];
  cg::grid_group grid = cg::this_grid();
  const u16* W = (const u16*)p.ws;
  const float* MOD = (const float*)(p.ws + B_MOD);
  u16* H = (u16*)ACT(p, 0);
  u16* Y = (u16*)ACT(p, 2);
  u16* G = (u16*)ACT(p, 4);
  u16* P = (u16*)ACT(p, 6);
  h16* Rr = (h16*)ACT(p, 2);
  h16* Kk = (h16*)ACT(p, 3);
  h16* Vv = (h16*)ACT(p, 4);
  u16* Dp = (u16*)ACT(p, 5);
  u16* L = (u16*)ACT(p, 0);
  h16* LO = (h16*)ACT(p, 6);
  u16* YP = (u16*)ACT(p, 1);
  u16* Y0 = (u16*)ACT(p, 0);
  u16* Y1 = (u16*)ACT(p, 5);
  u16* G1 = (u16*)ACT(p, 4);

#pragma unroll 1
  for (int ph = ph_lo; ph < ph_hi; ++ph) {
    int type, l = 0, pos = 0;
    if (ph == 0) type = T_PRE;
    else if (ph == 1) { type = T_ROW; pos = -1; }
    else {
      if (ph < 12) { l = 0; pos = ph - 2; }
      else if (ph < 18) { l = 1; pos = ph - 12; }
      else if (ph < 28) { l = 2; pos = ph - 18; }
      else { l = 3; pos = ph - 28; }
      if (l & 1) pos = pos == 0 ? 10 : (pos == 1 ? 5 : pos + 4);
      type = pos == 0 ? T_GEMM_BF16 : pos == 1 ? T_PREP1 : pos == 2 ? T_LORA : pos == 3 ? T_SCAN : pos == 4 ? T_MERGE
           : pos == 5 ? T_GEMM_BF16 : pos == 6 ? T_ROW : pos == 7 ? T_FFN : pos == 8 ? T_GEMM_BF16 : pos == 9 ? T_ROW : T_ODD;
    }
    const int reps = 1 + ((REP_MASK >> type) & 1);
#pragma unroll 1
    for (int rep = 0; rep < reps; ++rep) {
    const int i = l >> 1;
    const bool even = (l & 1) == 0;
    const bool ctx_later = l < 2;
    const bool ctx_in = l <= 2;
    const float* MODL = MOD + (size_t)l * 9 * 6144;
    const float* gn = p.norm_g + (size_t)l * 4 * D;
    GemmP g{};
    g.conv = 0;
    if (pos == 0) {
      g.A1 = H; g.A2 = H; g.lda1 = D; g.lda2 = D; g.ksplit = D; g.Bt = W + OFF_EVIN + i * SZ_EVIN; g.K = D;
      g.ntn = NEVP / 256; g.mtiles = ctx_in ? 136 : 128; g.C = P; g.ldc = NEVP;
    } else if (pos == 2) {
      g.A1 = L; g.A2 = L; g.lda1 = LORA_K; g.lda2 = LORA_K; g.ksplit = LORA_K; g.Bt = W + OFF_LORA + i * SZ_LORA; g.K = LORA_K;
      g.ntn = LORA_N / 256; g.mtiles = ctx_in ? 136 : 128;
      g.w0 = p.ev_w0 + i * 1024; g.a0 = p.ev_a0 + i * 1024; g.lout = LO;
    } else if (pos == 5) {
      if (even) { g.A1 = Y0; g.A2 = YP; g.lda1 = 512; g.lda2 = 512; g.ksplit = 512; g.Bt = W + OFF_EVOUT + i * SZ_SQ; }
      else { g.A1 = G1; g.A2 = G1; g.lda1 = D; g.lda2 = D; g.ksplit = D; g.Bt = W + OFF_ODOUT + i * SZ_SQ; }
      g.K = D; g.ntn = 4; g.mtiles = ctx_later ? 136 : 128; g.C = Y; g.ldc = D;
    } else if (pos == 7) {
      g.A1 = H; g.A2 = H; g.lda1 = D; g.lda2 = D; g.ksplit = D; g.Bt = W + OFF_FFNUP + l * SZ_FFNUP; g.K = D;
      g.ntn = 22; g.mtiles = ctx_later ? 136 : 128; g.conv = 1; g.C = G; g.ldc = DFF;
      g.cw = p.ffn_conv + (size_t)l * 3 * DFF; g.cwC = DFF;
    } else if (pos == 8) {
      g.A1 = G; g.A2 = G; g.lda1 = DFF; g.lda2 = DFF; g.ksplit = DFF; g.Bt = W + OFF_FFNDN + l * SZ_FFNDN; g.K = DFF;
      g.ntn = 4; g.mtiles = ctx_later ? 136 : 128; g.C = Y; g.ldc = D;
    } else if (pos == 10) {
      g.A1 = H; g.A2 = H; g.lda1 = D; g.lda2 = D; g.ksplit = D; g.Bt = W + OFF_ODIN + i * SZ_ODIN; g.K = D;
      g.ntn = 16; g.mtiles = ctx_later ? 136 : 128; g.conv = 1; g.C = G1; g.ldc = D;
      g.cw = p.od_conv + (size_t)i * 3 * D; g.cwC = D;
    }
    switch (type) {
      case T_PRE: pre_phase(p, smem); break;
      case T_ROW:
        if (pos == -1) row_phase(p, false, true, MT, nullptr, MOD, 0, p.norm_g, p.norm_g, MOD, 0, H);
        else if (pos == 6) row_phase(p, true, true, ctx_later ? MT : ML, Y, MODL, 2, gn + D, gn + 2 * D, MODL, 3, H);
        else row_phase(p, true, l < DEPTH - 1, ctx_later ? MT : ML, Y, MODL, 5, gn + 3 * D, gn + (l < DEPTH - 1 ? 4 * D : 0),
                       MODL + (l < DEPTH - 1 ? 9 * 6144 : 0), 0, H);
        break;
      case T_PREP1: prep1_phase(p, i, ctx_in ? MT : ML, P, Rr, Kk, Vv, L, Dp); break;
      case T_LORA:
        gemm_phase<4, EPI_LORA>(g, smem);
        g.A1 = Dp; g.A2 = Dp; g.lda1 = 512; g.lda2 = 512; g.ksplit = 512; g.Bt = W + OFF_POOL + i * SZ_POOL; g.K = 512;
        g.ntn = 2; g.mtiles = ctx_later ? 136 : 128; g.C = YP; g.ldc = 512;
        [[fallthrough]];
      case T_GEMM_BF16: gemm_phase<4, EPI_BF16>(g, smem); break;
      case T_SCAN:
        scan_phase(p, i, Rr, Kk, Vv, LO, LO + (size_t)MT * 512, LO + (size_t)2 * MT * 512, LO + (size_t)3 * MT * 512, Y0, Y1, smem);
        break;
      case T_MERGE:
        merge_phase(p, i, ctx_later ? MT : ML, Rr, Kk, Vv, LO + (size_t)2 * MT * 512, LO + (size_t)3 * MT * 512,
                    LO + (size_t)4 * MT * 512, Y0, Y1);
        break;
      case T_FFN: gemm_phase<4, EPI_FFN>(g, smem); break;
      case T_ODD: gemm_phase<3, EPI_ODD>(g, smem); break;
    }
    if (coop && (ph + 1 < ph_hi || rep + 1 < reps)) grid.sync();
    }
  }
}

extern "C" void kernel_launch(void* const* d_in, const int* in_sizes, int n_in, void* d_out, int out_size, void* d_ws,
                              size_t ws_size, hipStream_t stream) {
  Params p{};
  const float** pp = (const float**)&p;
  for (int k = 0; k < 28; ++k) pp[k] = (const float*)d_in[k];
  p.out = (float*)d_out;
  p.ws = (char*)d_ws;
  static int grid_blocks = 0;
  if (!grid_blocks) {
    int dev = 0, cus = 0, per_cu = 0;
    (void)hipGetDevice(&dev);
    (void)hipDeviceGetAttribute(&cus, hipDeviceAttributeMultiprocessorCount, dev);
    (void)hipOccupancyMaxActiveBlocksPerMultiprocessor(&per_cu, mega, NTHR, 0);
    if (per_cu > 1) per_cu = 1;
    if (per_cu < 1) per_cu = 1;
    grid_blocks = cus * per_cu;
    grid_blocks -= grid_blocks % 8;
  }
#if COOP
  int lo = 0, hi = NPHASES, coop = 1;
  void* args[] = {&p, &lo, &hi, &coop};
  hipError_t e = hipLaunchCooperativeKernel((void*)mega, dim3(grid_blocks), dim3(NTHR), args, 0, stream);
  if (e != hipSuccess) fprintf(stderr, "cooperative launch failed: %s (grid %d)\n", hipGetErrorString(e), grid_blocks);
#else
  for (int ph = 0; ph < NPHASES; ++ph) hipLaunchKernelGGL(mega, dim3(grid_blocks), dim3(NTHR), 0, stream, p, ph, ph + 1, 0);
#endif
}
```

```cpp
#include <hip/hip_runtime.h>
#include <hip/hip_bf16.h>
#include <hip/hip_cooperative_groups.h>
#include <cstdio>
namespace cg = cooperative_groups;

typedef unsigned short u16;
typedef _Float16 h16;
using bf16x8 = __attribute__((ext_vector_type(8))) short;
using f32x4 = __attribute__((ext_vector_type(4))) float;
typedef float f2 __attribute__((ext_vector_type(2)));
using h16x4 = __attribute__((ext_vector_type(4))) _Float16;
using u16x4 = __attribute__((ext_vector_type(4))) unsigned short;
using u16x8 = __attribute__((ext_vector_type(8))) unsigned short;

#ifndef REP_MASK
#define REP_MASK 0
#endif
#ifndef COOP
#define COOP 1
#endif

constexpr int D = 1024, NB = 8, SEQ = 4096, CTX = 256, DEPTH = 4;
constexpr int ML = NB * SEQ;
constexpr int MC = NB * CTX;
constexpr int MT = ML + MC;
constexpr int DFF = 2816;
constexpr int NEV = 2336, NEVP = 2560, DPROJ = 1824;
constexpr int NTHR = 512, NWV = 8;
constexpr int LORA_K = 384, LORA_N = 2560;
constexpr float RMS_EPS = 1e-6f, GN_EPS = 64e-5f;

constexpr size_t SZ_FFNUP = 5632ull * 1024, SZ_FFNDN = 1024ull * 2816, SZ_EVIN = 2560ull * 1024, SZ_SQ = 1024ull * 1024,
                 SZ_LORA = 2560ull * 384, SZ_POOL = 512ull * 512, SZ_ODIN = 3072ull * 1024;
constexpr size_t OFF_FFNUP = 0;
constexpr size_t OFF_FFNDN = OFF_FFNUP + 4 * SZ_FFNUP;
constexpr size_t OFF_EVIN = OFF_FFNDN + 4 * SZ_FFNDN;
constexpr size_t OFF_EVOUT = OFF_EVIN + 2 * SZ_EVIN;
constexpr size_t OFF_LORA = OFF_EVOUT + 2 * SZ_SQ;
constexpr size_t OFF_POOL = OFF_LORA + 2 * SZ_LORA;
constexpr size_t OFF_ODIN = OFF_POOL + 2 * SZ_POOL;
constexpr size_t OFF_ODOUT = OFF_ODIN + 2 * SZ_ODIN;
constexpr size_t W_ELEMS = OFF_ODOUT + 2 * SZ_SQ;
constexpr size_t B_MOD = W_ELEMS * 2;
constexpr size_t B_XC = B_MOD + 4ull * 9 * 6144 * 4;
constexpr size_t B_KINV = B_XC + (size_t)MC * D * 4;
constexpr size_t B_ACT = B_KINV + (size_t)MT * 8 * 4;
constexpr size_t UU = (size_t)MT * 512 * 2;
#define ACT(p, u) ((p).ws + B_ACT + (size_t)(u) * UU)

struct Params {
  const float *x, *c, *ctx, *c_ctx, *w_mod, *b_mod, *norm_g, *ffn_w_up, *ffn_conv, *ffn_w_down,
      *ev_w_in, *ev_w_out, *ev_mu, *ev_w0, *ev_w_up, *ev_a0, *ev_a_up, *ev_g_up, *ev_k_k, *ev_k_a, *ev_r_k,
      *ev_gn_w, *ev_gn_b, *ev_pool_w, *ev_pool_scale, *od_w_in, *od_conv, *od_w_out;
  float* out;
  char* ws;
};

__device__ __forceinline__ u16 f2bf(float f) {
  unsigned u = __float_as_uint(f);
  u += 0x7fffu + ((u >> 16) & 1u);
  return (u16)(u >> 16);
}
__device__ __forceinline__ float bf2f(u16 h) { return __uint_as_float(((unsigned)h) << 16); }
__device__ __forceinline__ float sigmoidf_(float x) { return 1.f / (1.f + __expf(-x)); }
__device__ __forceinline__ float siluf_(float x) { return x / (1.f + __expf(-x)); }

template <int CTRL>
__device__ __forceinline__ float dppf(float x) {
  return __builtin_bit_cast(float, __builtin_amdgcn_update_dpp(0, __builtin_bit_cast(int, x), CTRL, 0xf, 0xf, true));
}
__device__ __forceinline__ float row16_sum(float x) {
  x += dppf<0x128>(x);
  x += dppf<0x124>(x);
  x += dppf<0x122>(x);
  x += dppf<0x121>(x);
  return x;
}
__device__ __forceinline__ float row16_transpose_sum(const float (&q)[16], int j16) {
  const bool b3 = (j16 & 8) != 0, b2 = (j16 & 4) != 0, b1 = (j16 & 2) != 0, b0 = (j16 & 1) != 0;
  float r1[8], r2[4], r3[2];
#pragma unroll
  for (int i = 0; i < 8; ++i) { float keep = b3 ? q[i + 8] : q[i], send = b3 ? q[i] : q[i + 8]; r1[i] = keep + dppf<0x140>(send); }
#pragma unroll
  for (int i = 0; i < 4; ++i) { float keep = b2 ? r1[i + 4] : r1[i], send = b2 ? r1[i] : r1[i + 4]; r2[i] = keep + dppf<0x141>(send); }
#pragma unroll
  for (int i = 0; i < 2; ++i) { float keep = b1 ? r2[i + 2] : r2[i], send = b1 ? r2[i] : r2[i + 2]; r3[i] = keep + dppf<0x1B>(send); }
  float keep = b0 ? r3[1] : r3[0], send = b0 ? r3[0] : r3[1];
  return keep + dppf<0xB1>(send);
}
__device__ __forceinline__ float wave_sum(float x) {
  x = row16_sum(x);
  x += __shfl_xor(x, 16);
  x += __shfl_xor(x, 32);
  return x;
}

__device__ __forceinline__ int opaque_tid() { int t = threadIdx.x; asm volatile("" : "+v"(t)); return t; }
__device__ __forceinline__ int opaque_bid() { int t = blockIdx.x; asm volatile("" : "+s"(t)); return t; }
__device__ __forceinline__ int vblock(int bid) { return (bid & 7) * (gridDim.x >> 3) + (bid >> 3); }

__device__ __forceinline__ int map_col(int kind, int nd, int srcN) {
  if (kind == 0) return nd < srcN ? nd : -1;
  if (kind == 1) {
    int t = nd >> 7, r = nd & 127, wc = r >> 6, half = (r >> 5) & 1, j = r & 31;
    return half * DFF + t * 64 + wc * 32 + j;
  }
  int t = nd / 96, r = nd % 96, wc = r / 48, part = (r % 48) >> 4, j = r & 15;
  return part * 1024 + t * 32 + wc * 16 + j;
}

__device__ __forceinline__ size_t wt_off(int n, int k, int K, int BN) {
  int nb = n / BN, nr = n - nb * BN;
  int pos = ((k >> 3) & 7) ^ ((nr >> 1) & 7);
  return ((size_t)nb * (K >> 6) + (k >> 6)) * (size_t)(BN * 64) + nr * 64 + pos * 8 + (k & 7);
}

__device__ void conv_tile(const float* __restrict__ src, int srcN, int K, u16* __restrict__ dst, int kind, int tile,
                          int ntn64, float* sT) {
  const int TIDX = opaque_tid(); const int BIDX = opaque_bid(); (void)TIDX; (void)BIDX;
  int tn = tile % ntn64, tk = tile / ntn64;
  int n0 = tn * 64, k0 = tk * 64;
  int tx = TIDX & 63, ty = TIDX >> 6;
  int sc = map_col(kind, n0 + tx, srcN);
#pragma unroll
  for (int kk = ty; kk < 64; kk += 8) {
    float v = sc >= 0 ? src[(size_t)(k0 + kk) * srcN + sc] : 0.f;
    sT[kk * 65 + tx] = v;
  }
  __syncthreads();
  int n = TIDX >> 3, kq = (TIDX & 7) * 8;
  u16x8 o0;
#pragma unroll
  for (int e = 0; e < 8; ++e) o0[e] = f2bf(sT[(kq + e) * 65 + n]);
  u16* d = dst + wt_off(n0 + n, k0 + kq, K, kind == 2 ? 192 : 256);
  *(u16x8*)d = o0;
  __syncthreads();
}

__device__ __forceinline__ void pre_phase(const Params& p, char* smem) {
  const int TIDX = opaque_tid(); const int BIDX = opaque_bid(); (void)TIDX; (void)BIDX;
  u16* W = (u16*)p.ws;
  float* sT = (float*)smem;
  constexpr int T_UP = 88 * 16, T_DN = 16 * 44, T_EVIN = 40 * 16, T_SQ = 256, T_ODIN = 48 * 16;
  constexpr int N_BIG = 4 * T_UP + 4 * T_DN + 2 * (T_EVIN + T_SQ + T_ODIN + T_SQ);
  constexpr int N_LORA = 240, N_POOL = 64;
  constexpr int N_SMALL = 2 * (N_LORA + N_POOL);
  constexpr int N_MOD = 4 * 96;
  constexpr int N_ALL = N_BIG + N_SMALL + N_MOD;
  for (int it = BIDX; it < N_ALL; it += gridDim.x) {
    if (it < N_MOD) {
      int l = it / 96, c0 = (it % 96) * 64;
      float* sS = (float*)smem;
      float* sR = sS + 9 * 1024;
      for (int e = TIDX; e < 9 * 1024; e += NTHR) {
        int j = e >> 10, k = e & 1023;
        float cv = j < 8 ? p.c[j * 1024 + k] : p.c_ctx[k];
        sS[e] = siluf_(cv);
      }
      __syncthreads();
      int w = TIDX >> 6, lane = TIDX & 63;
      float acc[9];
#pragma unroll
      for (int j = 0; j < 9; ++j) acc[j] = 0.f;
      const float* wm = p.w_mod + (size_t)l * 1024 * 6144 + c0 + lane;
#pragma unroll 8
      for (int k = w * 128; k < w * 128 + 128; ++k) {
        float wv = wm[(size_t)k * 6144];
#pragma unroll
        for (int j = 0; j < 9; ++j) acc[j] += sS[j * 1024 + k] * wv;
      }
#pragma unroll
      for (int j = 0; j < 9; ++j) sR[(w * 9 + j) * 64 + lane] = acc[j];
      __syncthreads();
      for (int e = TIDX; e < 9 * 64; e += NTHR) {
        int j = e >> 6, cc = e & 63;
        float s = 0.f;
#pragma unroll
        for (int ww = 0; ww < 8; ++ww) s += sR[(ww * 9 + j) * 64 + cc];
        s += p.b_mod[l * 6144 + c0 + cc];
        ((float*)(p.ws + B_MOD))[(size_t)(l * 9 + j) * 6144 + c0 + cc] = s;
      }
      __syncthreads();
      continue;
    }
    int t = it - N_MOD;
    if (t < N_BIG) {
      if (t < 4 * T_UP) {
        int l = t / T_UP;
        conv_tile(p.ffn_w_up + (size_t)l * 1024 * 5632, 5632, 1024, W + OFF_FFNUP + l * SZ_FFNUP, 1, t % T_UP, 88, sT);
        continue;
      }
      t -= 4 * T_UP;
      if (t < 4 * T_DN) {
        int l = t / T_DN;
        conv_tile(p.ffn_w_down + (size_t)l * 2816 * 1024, 1024, 2816, W + OFF_FFNDN + l * SZ_FFNDN, 0, t % T_DN, 16, sT);
        continue;
      }
      t -= 4 * T_DN;
      if (t < 2 * T_EVIN) {
        int i = t / T_EVIN;
        conv_tile(p.ev_w_in + (size_t)i * 1024 * NEV, NEV, 1024, W + OFF_EVIN + i * SZ_EVIN, 0, t % T_EVIN, 40, sT);
        continue;
      }
      t -= 2 * T_EVIN;
      if (t < 2 * T_SQ) {
        int i = t / T_SQ;
        conv_tile(p.ev_w_out + (size_t)i * SZ_SQ, 1024, 1024, W + OFF_EVOUT + i * SZ_SQ, 0, t % T_SQ, 16, sT);
        continue;
      }
      t -= 2 * T_SQ;
      if (t < 2 * T_ODIN) {
        int i = t / T_ODIN;
        conv_tile(p.od_w_in + (size_t)i * 1024 * 3072, 3072, 1024, W + OFF_ODIN + i * SZ_ODIN, 2, t % T_ODIN, 48, sT);
        continue;
      }
      t -= 2 * T_ODIN;
      {
        int i = t / T_SQ;
        conv_tile(p.od_w_out + (size_t)i * SZ_SQ, 1024, 1024, W + OFF_ODOUT + i * SZ_SQ, 0, t % T_SQ, 16, sT);
        continue;
      }
    }
    t -= N_BIG;
    {
      int i = t / (N_LORA + N_POOL);
      int r = t % (N_LORA + N_POOL);
      if (r < N_LORA) {
        u16* dst = W + OFF_LORA + i * SZ_LORA;
        for (int e = r * 4096 + TIDX; e < r * 4096 + 4096; e += NTHR) {
          const int e_K = LORA_K;
          int n = e / LORA_K, k = e % LORA_K;
          int seg = n >> 9, cc = n & 511;
          float v = 0.f;
          if (seg == 0) { if (k < 32) v = p.ev_w_up[((size_t)(i * 2 + 0) * 32 + k) * 512 + cc]; }
          else if (seg == 1) { if (k >= 32 && k < 64) v = p.ev_w_up[((size_t)(i * 2 + 1) * 32 + (k - 32)) * 512 + cc]; }
          else if (seg == 2) { if (k >= 64 && k < 128) v = p.ev_a_up[((size_t)(i * 2 + 0) * 64 + (k - 64)) * 512 + cc]; }
          else if (seg == 3) { if (k >= 128 && k < 192) v = p.ev_a_up[((size_t)(i * 2 + 1) * 64 + (k - 128)) * 512 + cc]; }
          else { if (k >= 192 && k < 288) v = p.ev_g_up[((size_t)i * 96 + (k - 192)) * 512 + cc]; }
          dst[wt_off(n, k, e_K, 256)] = f2bf(v);
        }
      } else {
        r -= N_LORA;
        u16* dst = W + OFF_POOL + i * SZ_POOL;
        for (int e = r * 4096 + TIDX; e < r * 4096 + 4096; e += NTHR) {
          const int e_K = 512;
          int n = e >> 9, k = e & 511;
          float v = 0.f;
          int g = n >> 7;
          if ((k >> 7) == g) v = p.ev_pool_w[(((size_t)i * 4 + g) * 128 + (k & 127)) * 128 + (n & 127)] * p.ev_pool_scale[i * 512 + n];
          dst[wt_off(n, k, e_K, 256)] = f2bf(v);
        }
      }
    }
  }
}

__device__ __forceinline__ void row_phase(const Params& p, const bool HAS_Y, const bool HAS_H, int nrows, const u16* __restrict__ Y,
                          const float* __restrict__ modg  , int gate_chunk, const float* __restrict__ gy,
                          const float* __restrict__ gx, const float* __restrict__ modh  , int shift_chunk,
                          u16* __restrict__ H) {
  const int TIDX = opaque_tid(); const int BIDX = opaque_bid();
  const int lane = TIDX & 63;
  const int gw = BIDX * NWV + (TIDX >> 6), nw = gridDim.x * NWV;
  const int rpw = (nrows + nw - 1) / nw;
  const int r_begin = gw * rpw, r_end = min(r_begin + rpw, nrows);
  float* XC = (float*)(p.ws + B_XC);
  float4 gyv[4], gxv[4], gtv[4], shv[4], scv[4];
#pragma unroll
  for (int i = 0; i < 4; ++i) {
    gyv[i] = HAS_Y ? *(const float4*)(gy + i * 256 + lane * 4) : float4{0.f, 0.f, 0.f, 0.f};
    gxv[i] = HAS_H ? *(const float4*)(gx + i * 256 + lane * 4) : float4{0.f, 0.f, 0.f, 0.f};
    gtv[i] = shv[i] = scv[i] = float4{0.f, 0.f, 0.f, 0.f};
  }
  int bcur = -1;
#pragma unroll 1
  for (int row = r_begin; row < r_end; ++row) {
    const int b = row < ML ? (row >> 12) : 8;
    if (b != bcur) {
      bcur = b;
#pragma unroll
      for (int i = 0; i < 4; ++i) {
        const int c = i * 256 + lane * 4;
        if (HAS_Y) gtv[i] = *(const float4*)(modg + (size_t)b * 6144 + gate_chunk * 1024 + c);
        if (HAS_H) {
          shv[i] = *(const float4*)(modh + (size_t)b * 6144 + shift_chunk * 1024 + c);
          scv[i] = *(const float4*)(modh + (size_t)b * 6144 + (shift_chunk + 1) * 1024 + c);
        }
      }
    }
    float* xr = row < ML ? p.out + (size_t)row * D : XC + (size_t)(row - ML) * D;
    float4 xv[4];
    if (HAS_Y) {
#pragma unroll
      for (int i = 0; i < 4; ++i) xv[i] = *(const float4*)(xr + i * 256 + lane * 4);
      float yv[16];
      float ss = 0.f;
#pragma unroll
      for (int i = 0; i < 4; ++i) {
        u16x4 t = *(const u16x4*)(Y + (size_t)row * D + i * 256 + lane * 4);
#pragma unroll
        for (int e = 0; e < 4; ++e) { yv[i * 4 + e] = bf2f(t[e]); ss += yv[i * 4 + e] * yv[i * 4 + e]; }
      }
      ss = wave_sum(ss);
      float rstd = rsqrtf(ss * (1.f / D) + RMS_EPS);
#pragma unroll
      for (int i = 0; i < 4; ++i) {
        xv[i].x += gtv[i].x * (yv[i * 4 + 0] * rstd * gyv[i].x);
        xv[i].y += gtv[i].y * (yv[i * 4 + 1] * rstd * gyv[i].y);
        xv[i].z += gtv[i].z * (yv[i * 4 + 2] * rstd * gyv[i].z);
        xv[i].w += gtv[i].w * (yv[i * 4 + 3] * rstd * gyv[i].w);
      }
    } else {
      const float* src = row < ML ? p.x + (size_t)row * D : p.ctx + (size_t)(row - ML) * D;
#pragma unroll
      for (int i = 0; i < 4; ++i) xv[i] = *(const float4*)(src + i * 256 + lane * 4);
    }
#pragma unroll
    for (int i = 0; i < 4; ++i) *(float4*)(xr + i * 256 + lane * 4) = xv[i];
    if (HAS_H) {
      float ss = 0.f;
#pragma unroll
      for (int i = 0; i < 4; ++i) ss += xv[i].x * xv[i].x + xv[i].y * xv[i].y + xv[i].z * xv[i].z + xv[i].w * xv[i].w;
      ss = wave_sum(ss);
      float rstd = rsqrtf(ss * (1.f / D) + RMS_EPS);
#pragma unroll
      for (int i = 0; i < 4; ++i) {
        u16x4 o;
        o[0] = f2bf(xv[i].x * rstd * gxv[i].x * (1.f + scv[i].x) + shv[i].x);
        o[1] = f2bf(xv[i].y * rstd * gxv[i].y * (1.f + scv[i].y) + shv[i].y);
        o[2] = f2bf(xv[i].z * rstd * gxv[i].z * (1.f + scv[i].z) + shv[i].z);
        o[3] = f2bf(xv[i].w * rstd * gxv[i].w * (1.f + scv[i].w) + shv[i].w);
        *(u16x4*)(H + (size_t)row * D + i * 256 + lane * 4) = o;
      }
    }
  }
}

enum { EPI_BF16 = 0, EPI_FFN = 1, EPI_ODD = 2, EPI_LORA = 3 };

struct GemmP {
  const u16* A1; const u16* A2; int lda1, lda2, ksplit;
  const u16* Bt; int K; int ntn; int mtiles; int conv;
  u16* C; int ldc;
  const float* cw;
  int cwC;
  const float* w0; const float* a0; h16* lout;
};

__device__ __forceinline__ bool seg_start(int a) { return a < ML ? ((a & 63) == 0) : (((a - ML) & 255) == 0); }
__device__ __forceinline__ bool seg_end(int a) { return a < ML ? ((a & 63) == 63) : (((a - ML) & 255) == 255); }

#define RAW_BARRIER() do { asm volatile("s_waitcnt lgkmcnt(0)" ::: "memory"); __builtin_amdgcn_s_barrier(); } while (0)
constexpr int GSTAGE = 65536;
constexpr int NSTG = 2;
constexpr int SMEM_BYTES = NSTG * GSTAGE;

template <int NT, int EPI>
__device__ __forceinline__ void gemm_phase(const GemmP& g, char* smem) {
  const int TIDX = opaque_tid(); const int BIDX = opaque_bid(); (void)TIDX; (void)BIDX;
  constexpr int BN = 64 * NT;
  const int tid = TIDX, wid = tid >> 6, lane = tid & 63, wr = wid >> 2, wc = wid & 3, fr = lane & 15, fq = lane >> 4;
  const int ntiles = g.mtiles * g.ntn;
  const int sr = tid >> 3;
  const int scol = ((tid & 7) ^ ((sr >> 1) & 7)) * 8;
  const int sw0 = ((fq) ^ (fr >> 1)) * 8, sw1 = ((4 + fq) ^ (fr >> 1)) * 8;
#pragma unroll 1
  for (int tile = vblock(BIDX); tile < ntiles; tile += gridDim.x) {
    int grp_ = tile / (8 * g.ntn), rem_ = tile - grp_ * 8 * g.ntn;
    int nt = rem_ >> 3, mt = grp_ * 8 + (rem_ & 7);
    const int row0 = mt * 256;
    const int n0 = nt * BN;
    f32x4 acc[8][NT];
#pragma unroll
    for (int m = 0; m < 8; ++m)
#pragma unroll
      for (int n = 0; n < NT; ++n) acc[m][n] = f32x4{0.f, 0.f, 0.f, 0.f};
    const int nk = g.K >> 6;
    const u16* bbase = g.Bt + (size_t)nt * (g.K >> 6) * (BN * 64) + tid * 8;
    auto piece = [&](int t, int st, int q) {
      char* base = smem + st * GSTAGE + tid * 16;
      int kk = t << 6;
      if (q < 4) {
        const u16* Ab; int lda;
        if (kk < g.ksplit) { Ab = g.A1 + kk; lda = g.lda1; } else { Ab = g.A2 + (kk - g.ksplit); lda = g.lda2; }
        const u16* ap = Ab + (size_t)(row0 + sr + 64 * q) * lda + scol;
        __builtin_amdgcn_global_load_lds((const unsigned*)(ap), (unsigned*)(base + q * 8192), 16, 0, 0);
      } else {
        const int qq = (NT == 3 && q == 7) ? 2 : q - 4;
        __builtin_amdgcn_global_load_lds((const unsigned*)(bbase + (size_t)t * (BN * 64) + qq * 4096), (unsigned*)(base + 32768 + (q - 4) * 8192), 16, 0, 0);
      }
    };
    auto issue = [&](int t, int st) {
#pragma unroll
      for (int q = 0; q < 8; ++q) piece(t, st, q);
    };
    issue(0, 0);
#pragma unroll 1
    for (int t = 0; t < nk; ++t) {
      const int st = t & 1;
      asm volatile("s_waitcnt vmcnt(0)" ::: "memory");
      RAW_BARRIER();
      const bool more = t + 1 < nk;
      const u16* SA = (const u16*)(smem + st * GSTAGE);
      const u16* SB = (const u16*)(smem + st * GSTAGE + 32768);
      const u16* pa = SA + (wr * 128 + fr) * 64;
      const u16* pb = SB + (wc * 16 * NT + fr) * 64;
      bf16x8 Ac[4], An[4], Bc[NT], Bn[NT];
#pragma unroll
      for (int n = 0; n < NT; ++n) Bc[n] = *(const bf16x8*)(pb + n * 16 * 64 + sw0);
#pragma unroll
      for (int m = 0; m < 4; ++m) Ac[m] = *(const bf16x8*)(pa + m * 16 * 64 + sw0);
#pragma unroll
      for (int u = 0; u < 4; ++u) {
        const int mh = u & 1;
        if (u < 3) {
          const int nmh = (u + 1) & 1, nsw = ((u + 1) >> 1) ? sw1 : sw0;
#pragma unroll
          for (int m = 0; m < 4; ++m) An[m] = *(const bf16x8*)(pa + (nmh * 64 + m * 16) * 64 + nsw);
        }
        if (u == 1) {
#pragma unroll
          for (int n = 0; n < NT; ++n) Bn[n] = *(const bf16x8*)(pb + n * 16 * 64 + sw1);
        }
#pragma unroll
        for (int m = 0; m < 4; ++m) {
#pragma unroll
          for (int n = 0; n < NT; ++n)
            acc[mh * 4 + m][n] = __builtin_amdgcn_mfma_f32_16x16x32_bf16(Ac[m], Bc[n], acc[mh * 4 + m][n], 0, 0, 0);
          if (u < 2) {
            if (more) piece(t + 1, st ^ 1, u * 4 + m);
          }
        }
        if (u < 3) {
#pragma unroll
          for (int m = 0; m < 4; ++m) Ac[m] = An[m];
        }
        if (u == 1) {
#pragma unroll
          for (int n = 0; n < NT; ++n) Bc[n] = Bn[n];
        }
      }
    }
    __syncthreads();
    if (EPI == EPI_BF16) {
#pragma unroll
      for (int m = 0; m < 8; ++m)
#pragma unroll
        for (int j = 0; j < 4; ++j) {
          int r = wr * 128 + m * 16 + fq * 4 + j;
          size_t ro = (size_t)(row0 + r) * g.ldc + n0 + wc * 16 * NT + fr;
#pragma unroll
          for (int n = 0; n < NT; ++n) g.C[ro + n * 16] = f2bf(acc[m][n][j]);
        }
    } else if (EPI == EPI_LORA) {
      const int seg = n0 >> 9;
      h16* dst = g.lout + (size_t)seg * MT * 512 + (size_t)row0 * 512 + (n0 & 511) + wc * 16 * NT + fr;
      float bias[NT];
#pragma unroll
      for (int n = 0; n < NT; ++n) {
        int cc = (n0 & 511) + wc * 16 * NT + n * 16 + fr;
        bias[n] = seg < 2 ? g.w0[seg * 512 + cc] : (seg < 4 ? g.a0[(seg - 2) * 512 + cc] : 0.f);
      }
      auto lora_store = [&](auto fn) {
        unsigned ro = (unsigned)(wr * 128 + fq * 4) * 512;
#pragma unroll
        for (int m = 0; m < 8; ++m) {
          asm volatile("" : "+v"(ro));
#pragma unroll
          for (int n = 0; n < NT; ++n)
#pragma unroll
            for (int j = 0; j < 4; ++j)
              dst[ro + j * 512 + n * 16] = (h16)fn(acc[m][n][j] + bias[n]);
          ro += 16 * 512;
          __syncthreads();
        }
      };
      if (seg < 2) {
        lora_store([](float v) { float sp = -v > 20.f ? -v : __logf(1.f + __expf(-v)); return -__expf(-sp - 0.5f); });
      } else if (seg < 4) {
        lora_store([](float v) { return sigmoidf_(v); });
      } else {
        lora_store([](float v) { return v; });
      }
    } else {
      constexpr int CW = (EPI == EPI_FFN) ? 128 : 64;
      constexpr int CPW = CW / 4;
      constexpr int NA = CPW / 16;
      float* sC = (float*)smem;
      constexpr int LDC = (EPI == EPI_FFN) ? DFF : D;
      const int colofs = wc * CPW + fr;
      {
        float* sb = sC + (wr * 128 + fq * 4) * CW + colofs;
#pragma unroll
        for (int m = 0; m < 8; ++m)
#pragma unroll
          for (int n = 0; n < NA; ++n)
#pragma unroll
            for (int j = 0; j < 4; j += 3) {
              float u = (EPI == EPI_FFN) ? acc[m][n][j] : acc[m][1][j] * acc[m][2][j];
              sb[(m * 16 + j) * CW + n * 16] = u;
            }
      }
      __syncthreads();
      float cwv[NA][3];
#pragma unroll
      for (int n = 0; n < NA; ++n) {
        int ch = nt * CW + colofs + n * 16;
        cwv[n][0] = g.cw[ch]; cwv[n][1] = g.cw[g.cwC + ch]; cwv[n][2] = g.cw[2 * g.cwC + ch];
      }
      const bool lat = row0 < ML;
      const int segmask = lat ? 63 : 255;
      u16* const cbase = g.C + (size_t)row0 * LDC + nt * CW + colofs;
      int rb = wr * 128 + fq * 4;
#pragma unroll
      for (int m = 0; m < 8; ++m) {
        asm volatile("" : "+v"(rb));
        const int so = rb * CW + colofs;
        const unsigned co = (unsigned)rb * LDC;
#pragma unroll
        for (int n = 0; n < NA; ++n) {
          float c4[4];
#pragma unroll
          for (int j = 0; j < 4; ++j) c4[j] = (EPI == EPI_FFN) ? acc[m][n][j] : acc[m][1][j] * acc[m][2][j];
          const float pv0 = sC[max(so - CW, 0) + n * 16];
          const float nv3 = sC[min(so + 4 * CW, 255 * CW + colofs) + n * 16];
#pragma unroll
          for (int j = 0; j < 4; ++j) {
            const int r = rb + j;
            float pv = (j == 0) ? pv0 : c4[j - 1];
            float nv = (j == 3) ? nv3 : c4[j + 1];
            pv = ((r & segmask) == 0) ? 0.f : pv;
            nv = ((r & segmask) == segmask) ? 0.f : nv;
            const float cv = cwv[n][0] * pv + cwv[n][1] * c4[j] + cwv[n][2] * nv;
            const float o = (EPI == EPI_FFN) ? siluf_(cv) * acc[m][n + 2][j] : acc[m][0][j] * cv;
            cbase[co + j * LDC + n * 16] = f2bf(o);
          }
        }
        rb += 16;
        __syncthreads();
      }
      __syncthreads();
    }
  }
}

using f16x8 = __attribute__((ext_vector_type(8))) _Float16;
__device__ __forceinline__ void prep1_phase(const Params& p, int i, int nrows, const u16* __restrict__ P, h16* __restrict__ R,
                                            h16* __restrict__ Kk, h16* __restrict__ V, u16* __restrict__ L, u16* __restrict__ Dp) {
  const int TIDX = opaque_tid(); const int BIDX = opaque_bid();
  const int lane = TIDX & 63;
  const int gw = BIDX * NWV + (TIDX >> 6), nw = gridDim.x * NWV;
  const float* mu0 = p.ev_mu + (size_t)i * 2 * DPROJ;
  const float* mu1 = mu0 + DPROJ;
  float* KINV = (float*)(p.ws + B_KINV);
  float m0[3][8], m1[3][8], kkp[8], lm0[8], lm1[8];
#pragma unroll
  for (int q = 0; q < 3; ++q)
#pragma unroll
    for (int e = 0; e < 8; ++e) { int c = (lane + 64 * q) * 8 + e; m0[q][e] = mu0[c]; m1[q][e] = mu1[c]; }
#pragma unroll
  for (int e = 0; e < 8; ++e) kkp[e] = p.ev_k_k[i * 512 + lane * 8 + e];
  const int ll = lane < 36 ? lane : 35;
#pragma unroll
  for (int e = 0; e < 8; ++e) { lm0[e] = mu0[1536 + ll * 8 + e]; lm1[e] = mu1[1536 + ll * 8 + e]; }
  const int gi = lane >> 4, half = 1 << gi;
  const u16x8 zero8 = {0, 0, 0, 0, 0, 0, 0, 0};
#pragma unroll 1
  for (int row = gw; row < nrows; row += nw) {
    const bool lat = row < ML;
    const int t = lat ? (row & 4095) : ((row - ML) & 255);
    const int tl = lat ? 4095 : 255;
    const bool hp = t > 0, hn = t < tl;
    const u16* pc = P + (size_t)row * NEVP;
    const u16* pp = hp ? pc - NEVP : pc;
    const u16* pn = hn ? pc + NEVP : pc;
    u16x8 cur[3], pv[3], nv[3];
#pragma unroll
    for (int q = 0; q < 3; ++q) {
      int c = (lane + 64 * q) * 8;
      cur[q] = *(const u16x8*)(pc + c); pv[q] = *(const u16x8*)(pp + c); nv[q] = *(const u16x8*)(pn + c);
    }
    u16x8 lc = *(const u16x8*)(pc + 1536 + ll * 8), lp = *(const u16x8*)(pp + 1536 + ll * 8), ln = *(const u16x8*)(pn + 1536 + ll * 8);
    const int pos = lat ? (row & 63) : ((row - ML) & 255);
    const int Lr = lat ? 64 : 256;
    u16x8 pw[16];
#pragma unroll
    for (int dd = 0; dd < 16; ++dd) {
      int jj = min(max(pos + dd - 8, 0), Lr - 1);
      pw[dd] = *(const u16x8*)(pc + (ptrdiff_t)(jj - pos) * NEVP + DPROJ + lane * 8);
    }
    float ssq = 0.f;
#pragma unroll
    for (int q = 0; q < 3; ++q) {
      f16x8 o;
#pragma unroll
      for (int e = 0; e < 8; ++e) {
        float c = bf2f(cur[q][e]);
        float a = hp ? bf2f(pv[q][e]) : 0.f;
        float n = hn ? bf2f(nv[q][e]) : 0.f;
        float sv = c + m0[q][e] * (a - c) + m1[q][e] * (n - c);
        o[e] = (h16)sv;
        if (q == 1) { float kr = sv * kkp[e]; ssq += kr * kr; }
      }
      h16* dst = q == 0 ? R : (q == 1 ? Kk : V);
      *(f16x8*)(dst + (size_t)row * 512 + lane * 8) = o;
    }
    ssq += __shfl_xor(ssq, 1);
    ssq += __shfl_xor(ssq, 2);
    ssq += __shfl_xor(ssq, 4);
    if ((lane & 7) == 0) KINV[(size_t)row * 8 + (lane >> 3)] = rsqrtf(fmaxf(ssq, 1e-24f));
    if (lane < 48) {
      u16x8 o = zero8;
      if (lane < 36) {
#pragma unroll
        for (int e = 0; e < 8; ++e) {
          float c = bf2f(lc[e]);
          float a = hp ? bf2f(lp[e]) : 0.f;
          float n = hn ? bf2f(ln[e]) : 0.f;
          float sv = c + lm0[e] * (a - c) + lm1[e] * (n - c);
          float ov = lane < 8 ? tanhf(sv) : (lane < 24 ? sv : sigmoidf_(sv));
          o[e] = f2bf(ov);
        }
      }
      *(u16x8*)(L + (size_t)row * LORA_K + lane * 8) = o;
    }
    {
      float sum[8];
#pragma unroll
      for (int e = 0; e < 8; ++e) sum[e] = 0.f;
#pragma unroll
      for (int dd = 0; dd < 16; ++dd) {
        int d = dd - 8, jj = pos + d;
        bool ok = d >= -half && d < half && jj >= 0 && jj < Lr;
        float mk = ok ? 1.f : 0.f;
#pragma unroll
        for (int e = 0; e < 8; ++e) sum[e] += mk * bf2f(pw[dd][e]);
      }
      int lo = max(pos - half, 0), hi = min(pos + half, Lr);
      float inv = 1.f / (float)(hi - lo);
      u16x8 o;
#pragma unroll
      for (int e = 0; e < 8; ++e) o[e] = f2bf(sum[e] * inv - bf2f(pw[8][e]));
      *(u16x8*)(Dp + (size_t)row * 512 + lane * 8) = o;
    }
  }
}

__device__ __forceinline__ void scan_phase(const Params& p, int i, const h16* __restrict__ R, const h16* __restrict__ Kk,
                                           const h16* __restrict__ V, const h16* __restrict__ W0, const h16* __restrict__ W1,
                                           const h16* __restrict__ A0, const h16* __restrict__ A1, u16* __restrict__ Y0,
                                           u16* __restrict__ Y1, char* smem) {
  const int TIDX = opaque_tid(); const int BIDX = opaque_bid();
  const int tid = TIDX, wid = tid >> 6, lane = tid & 63;
  const int grp = lane >> 4, j16 = lane & 15;
  const float* KINV = (const float*)(p.ws + B_KINV);
  float* sOp = (float*)smem;
  const bool stager = tid >= 256;
  const int stid = tid & 255;
#pragma unroll 1
  for (int item = BIDX; item < 256; item += gridDim.x) {
    int half = item & 1, dir = (item >> 1) & 1, h = (item >> 2) & 7, b = item >> 5;
    const h16* Wd = dir ? W1 : W0;
    const h16* Ad = dir ? A1 : A0;
    u16* Yd = dir ? Y1 : Y0;
    int ss = stid >> 4, c4 = (stid & 15) * 4;
    float kkp[4], kap[4];
#pragma unroll
    for (int e = 0; e < 4; ++e) { kkp[e] = p.ev_k_k[i * 512 + h * 64 + c4 + e]; kap[e] = p.ev_k_a[i * 512 + h * 64 + c4 + e]; }
    const int rowA = half * 32 + (wid & 3) * 8 + grp * 2;
    f2 S0a = {0.f, 0.f}, S0b = {0.f, 0.f}, S1a = {0.f, 0.f}, S1b = {0.f, 0.f};

    auto tok_row = [&](int cidx, int s) -> int {
      if (cidx < 16) { int q = cidx * 16 + s; int tk = dir ? 255 - q : q; return ML + b * 256 + tk; }
      int q = (cidx - 16) * 16 + s; int tk = dir ? 4095 - q : q; return b * 4096 + tk;
    };
    h16x4 lr, lk, lv, lw, la; float linv;
    auto gload = [&](int cidx) {
      size_t o = (size_t)tok_row(cidx, ss) * 512 + h * 64 + c4;
      lr = *(const h16x4*)(R + o); lk = *(const h16x4*)(Kk + o); lv = *(const h16x4*)(V + o);
      lw = *(const h16x4*)(Wd + o); la = *(const h16x4*)(Ad + o);
      linv = KINV[(size_t)tok_row(cidx, ss) * 8 + h];
    };
    auto lstore = [&](int buf) {
      float* base = sOp + (size_t)buf * 16 * 6 * 64 + ss * 6 * 64 + c4;
      float4 kk4, w4, b4, kd4, r4, v4;
      float* kkf = (float*)&kk4; float* wf = (float*)&w4; float* bfp = (float*)&b4; float* kdf = (float*)&kd4;
      float* rf = (float*)&r4; float* vf = (float*)&v4;
#pragma unroll
      for (int e = 0; e < 4; ++e) {
        float k = (float)lk[e], a = (float)la[e];
        float kk = k * kkp[e] * linv;
        kkf[e] = kk;
        wf[e] = __expf((float)lw[e]);
        bfp[e] = kk * a;
        kdf[e] = k * (1.f + (a - 1.f) * kap[e]);
        rf[e] = (float)lr[e];
        vf[e] = (float)lv[e];
      }
      *(float4*)(base + 0 * 64) = kk4; *(float4*)(base + 1 * 64) = w4; *(float4*)(base + 2 * 64) = b4;
      *(float4*)(base + 3 * 64) = kd4; *(float4*)(base + 4 * 64) = r4; *(float4*)(base + 5 * 64) = v4;
    };
    __syncthreads();
    if (stager) { gload(0); lstore(0); }
    __syncthreads();
    constexpr int NCH = 16 + 256;
#pragma unroll 1
    for (int cidx = 0; cidx < NCH; ++cidx) {
      int buf = cidx & 1;
      if (stager) {
        if (cidx + 1 < NCH) { gload(cidx + 1); lstore(buf ^ 1); }
      } else {
        const float* cb = sOp + (size_t)buf * 16 * 6 * 64;
        float qa0[16], qa1[16];
        const float* lb = cb + j16 * 4;
        const float* vb = cb + 5 * 64 + rowA;
        float4 c_kk = *(const float4*)(lb + 0 * 64), c_w = *(const float4*)(lb + 1 * 64), c_b = *(const float4*)(lb + 2 * 64),
               c_kd = *(const float4*)(lb + 3 * 64), c_r = *(const float4*)(lb + 4 * 64);
        float2 c_v = *(const float2*)(vb);
#pragma unroll
        for (int s = 0; s < 16; ++s) {
          float4 n_kk, n_w, n_b, n_kd, n_r; float2 n_v;
          if (s < 15) {
            const float* nb = lb + (s + 1) * 6 * 64;
            n_kk = *(const float4*)(nb + 0 * 64); n_w = *(const float4*)(nb + 1 * 64); n_b = *(const float4*)(nb + 2 * 64);
            n_kd = *(const float4*)(nb + 3 * 64); n_r = *(const float4*)(nb + 4 * 64);
            n_v = *(const float2*)(vb + (s + 1) * 6 * 64);
          }
          const f2 kka = {c_kk.x, c_kk.y}, kkb = {c_kk.z, c_kk.w}, wa = {c_w.x, c_w.y}, wb = {c_w.z, c_w.w};
          const f2 ba = {c_b.x, c_b.y}, bb = {c_b.z, c_b.w}, kda = {c_kd.x, c_kd.y}, kdb = {c_kd.z, c_kd.w};
          const f2 ra = {c_r.x, c_r.y}, rb = {c_r.z, c_r.w};
          f2 t0 = __builtin_elementwise_fma(S0b, kkb, S0a * kka);
          f2 t1 = __builtin_elementwise_fma(S1b, kkb, S1a * kka);
          float sa0 = t0.x + t0.y, sa1 = t1.x + t1.y;
          const f2 v0 = {c_v.x, c_v.x}, v1 = {c_v.y, c_v.y};
          f2 u0a = v0 * kda, u0b = v0 * kdb, u1a = v1 * kda, u1b = v1 * kdb;
          sa0 = row16_sum(sa0);
          sa1 = row16_sum(sa1);
          const f2 ns0 = {-sa0, -sa0}, ns1 = {-sa1, -sa1};
          u0a = __builtin_elementwise_fma(ns0, ba, u0a); u0b = __builtin_elementwise_fma(ns0, bb, u0b);
          u1a = __builtin_elementwise_fma(ns1, ba, u1a); u1b = __builtin_elementwise_fma(ns1, bb, u1b);
          S0a = __builtin_elementwise_fma(S0a, wa, u0a); S0b = __builtin_elementwise_fma(S0b, wb, u0b);
          S1a = __builtin_elementwise_fma(S1a, wa, u1a); S1b = __builtin_elementwise_fma(S1b, wb, u1b);
          f2 q0 = __builtin_elementwise_fma(S0b, rb, S0a * ra);
          f2 q1 = __builtin_elementwise_fma(S1b, rb, S1a * ra);
          qa0[s] = q0.x + q0.y; qa1[s] = q1.x + q1.y;
          if (s < 15) { c_kk = n_kk; c_w = n_w; c_b = n_b; c_kd = n_kd; c_r = n_r; c_v = n_v; }
        }
        const float yk0 = row16_transpose_sum(qa0, j16), yk1 = row16_transpose_sum(qa1, j16);
        size_t o = (size_t)tok_row(cidx, j16) * 512 + h * 64 + rowA;
        unsigned pk = (unsigned)f2bf(yk0) | ((unsigned)f2bf(yk1) << 16);
        *(unsigned*)(Yd + o) = pk;
      }
      __syncthreads();
    }
  }
}

__device__ __forceinline__ float grp8_sum(float x) {
  x += __shfl_xor(x, 1);
  x += __shfl_xor(x, 2);
  x += __shfl_xor(x, 4);
  return x;
}
__device__ __forceinline__ void merge_phase(const Params& p, int i, int nrows, const h16* __restrict__ R, const h16* __restrict__ Kk,
                                            const h16* __restrict__ V, const h16* __restrict__ A0, const h16* __restrict__ A1,
                                            const h16* __restrict__ Gt, u16* Y0, const u16* __restrict__ Y1) {
  const int TIDX = opaque_tid(); const int BIDX = opaque_bid();
  const int lane = TIDX & 63;
  const int gw = BIDX * NWV + (TIDX >> 6), nw = gridDim.x * NWV;
  float gnw[8], gnb[8], ka[8], rk[8];
#pragma unroll
  for (int e = 0; e < 8; ++e) {
    int c = i * 512 + lane * 8 + e;
    gnw[e] = p.ev_gn_w[c]; gnb[e] = p.ev_gn_b[c]; ka[e] = p.ev_k_a[c]; rk[e] = p.ev_r_k[c];
  }
#pragma unroll 1
  for (int row = gw; row < nrows; row += nw) {
    size_t o = (size_t)row * 512 + lane * 8;
    u16x8 y0 = *(const u16x8*)(Y0 + o), y1 = *(const u16x8*)(Y1 + o);
    f16x8 k8 = *(const f16x8*)(Kk + o), a08 = *(const f16x8*)(A0 + o), a18 = *(const f16x8*)(A1 + o);
    f16x8 r8 = *(const f16x8*)(R + o), v8 = *(const f16x8*)(V + o), g8 = *(const f16x8*)(Gt + o);
    float y[8], s = 0.f, cf = 0.f;
#pragma unroll
    for (int e = 0; e < 8; ++e) {
      y[e] = bf2f(y0[e]) + bf2f(y1[e]);
      s += y[e];
      float kd = (float)k8[e] * (2.f + ((float)a08[e] + (float)a18[e] - 2.f) * ka[e]);
      cf += (float)r8[e] * rk[e] * kd;
    }
    float mean = grp8_sum(s) * (1.f / 64.f);
    cf = grp8_sum(cf);
    float vs = 0.f;
#pragma unroll
    for (int e = 0; e < 8; ++e) { y[e] -= mean; vs += y[e] * y[e]; }
    float rs = rsqrtf(grp8_sum(vs) * (1.f / 64.f) + GN_EPS);
    u16x8 ov;
#pragma unroll
    for (int e = 0; e < 8; ++e) ov[e] = f2bf((y[e] * rs * gnw[e] + gnb[e] + cf * (float)v8[e]) * (float)g8[e]);
    *(u16x8*)(Y0 + o) = ov;
  }
}

constexpr int NPHASES = 34;
enum { T_PRE = 0, T_ROW, T_GEMM_BF16, T_PREP1, T_LORA, T_SCAN, T_MERGE, T_FFN, T_ODD };

__global__ void __launch_bounds__(NTHR, 1) mega(Params p, int ph_lo, int ph_hi, int coop) {
  __shared__ __attribute__((aligned(16))) char smem[SMEM_BYTES];
  cg::grid_group grid = cg::this_grid();
  const u16* W = (const u16*)p.ws;
  const float* MOD = (const float*)(p.ws + B_MOD);
  u16* H = (u16*)ACT(p, 0);
  u16* Y = (u16*)ACT(p, 2);
  u16* G = (u16*)ACT(p, 4);
  u16* P = (u16*)ACT(p, 6);
  h16* Rr = (h16*)ACT(p, 2);
  h16* Kk = (h16*)ACT(p, 3);
  h16* Vv = (h16*)ACT(p, 4);
  u16* Dp = (u16*)ACT(p, 5);
  u16* L = (u16*)ACT(p, 0);
  h16* LO = (h16*)ACT(p, 6);
  u16* YP = (u16*)ACT(p, 1);
  u16* Y0 = (u16*)ACT(p, 0);
  u16* Y1 = (u16*)ACT(p, 5);
  u16* G1 = (u16*)ACT(p, 4);

#pragma unroll 1
  for (int ph = ph_lo; ph < ph_hi; ++ph) {
    int type, l = 0, pos = 0;
    if (ph == 0) type = T_PRE;
    else if (ph == 1) { type = T_ROW; pos = -1; }
    else {
      if (ph < 12) { l = 0; pos = ph - 2; }
      else if (ph < 18) { l = 1; pos = ph - 12; }
      else if (ph < 28) { l = 2; pos = ph - 18; }
      else { l = 3; pos = ph - 28; }
      if (l & 1) pos = pos == 0 ? 10 : (pos == 1 ? 5 : pos + 4);
      type = pos == 0 ? T_GEMM_BF16 : pos == 1 ? T_PREP1 : pos == 2 ? T_LORA : pos == 3 ? T_SCAN : pos == 4 ? T_MERGE
           : pos == 5 ? T_GEMM_BF16 : pos == 6 ? T_ROW : pos == 7 ? T_FFN : pos == 8 ? T_GEMM_BF16 : pos == 9 ? T_ROW : T_ODD;
    }
    const int reps = 1 + ((REP_MASK >> type) & 1);
#pragma unroll 1
    for (int rep = 0; rep < reps; ++rep) {
    const int i = l >> 1;
    const bool even = (l & 1) == 0;
    const bool ctx_later = l < 2;
    const bool ctx_in = l <= 2;
    const float* MODL = MOD + (size_t)l * 9 * 6144;
    const float* gn = p.norm_g + (size_t)l * 4 * D;
    GemmP g{};
    g.conv = 0;
    if (pos == 0) {
      g.A1 = H; g.A2 = H; g.lda1 = D; g.lda2 = D; g.ksplit = D; g.Bt = W + OFF_EVIN + i * SZ_EVIN; g.K = D;
      g.ntn = NEVP / 256; g.mtiles = ctx_in ? 136 : 128; g.C = P; g.ldc = NEVP;
    } else if (pos == 2) {
      g.A1 = L; g.A2 = L; g.lda1 = LORA_K; g.lda2 = LORA_K; g.ksplit = LORA_K; g.Bt = W + OFF_LORA + i * SZ_LORA; g.K = LORA_K;
      g.ntn = LORA_N / 256; g.mtiles = ctx_in ? 136 : 128;
      g.w0 = p.ev_w0 + i * 1024; g.a0 = p.ev_a0 + i * 1024; g.lout = LO;
    } else if (pos == 5) {
      if (even) { g.A1 = Y0; g.A2 = YP; g.lda1 = 512; g.lda2 = 512; g.ksplit = 512; g.Bt = W + OFF_EVOUT + i * SZ_SQ; }
      else { g.A1 = G1; g.A2 = G1; g.lda1 = D; g.lda2 = D; g.ksplit = D; g.Bt = W + OFF_ODOUT + i * SZ_SQ; }
      g.K = D; g.ntn = 4; g.mtiles = ctx_later ? 136 : 128; g.C = Y; g.ldc = D;
    } else if (pos == 7) {
      g.A1 = H; g.A2 = H; g.lda1 = D; g.lda2 = D; g.ksplit = D; g.Bt = W + OFF_FFNUP + l * SZ_FFNUP; g.K = D;
      g.ntn = 22; g.mtiles = ctx_later ? 136 : 128; g.conv = 1; g.C = G; g.ldc = DFF;
      g.cw = p.ffn_conv + (size_t)l * 3 * DFF; g.cwC = DFF;
    } else if (pos == 8) {
      g.A1 = G; g.A2 = G; g.lda1 = DFF; g.lda2 = DFF; g.ksplit = DFF; g.Bt = W + OFF_FFNDN + l * SZ_FFNDN; g.K = DFF;
      g.ntn = 4; g.mtiles = ctx_later ? 136 : 128; g.C = Y; g.ldc = D;
    } else if (pos == 10) {
      g.A1 = H; g.A2 = H; g.lda1 = D; g.lda2 = D; g.ksplit = D; g.Bt = W + OFF_ODIN + i * SZ_ODIN; g.K = D;
      g.ntn = 16; g.mtiles = ctx_later ? 136 : 128; g.conv = 1; g.C = G1; g.ldc = D;
      g.cw = p.od_conv + (size_t)i * 3 * D; g.cwC = D;
    }
    switch (type) {
      case T_PRE: pre_phase(p, smem); break;
      case T_ROW:
        if (pos == -1) row_phase(p, false, true, MT, nullptr, MOD, 0, p.norm_g, p.norm_g, MOD, 0, H);
        else if (pos == 6) row_phase(p, true, true, ctx_later ? MT : ML, Y, MODL, 2, gn + D, gn + 2 * D, MODL, 3, H);
        else row_phase(p, true, l < DEPTH - 1, ctx_later ? MT : ML, Y, MODL, 5, gn + 3 * D, gn + (l < DEPTH - 1 ? 4 * D : 0),
                       MODL + (l < DEPTH - 1 ? 9 * 6144 : 0), 0, H);
        break;
      case T_PREP1: prep1_phase(p, i, ctx_in ? MT : ML, P, Rr, Kk, Vv, L, Dp); break;
      case T_LORA:
        gemm_phase<4, EPI_LORA>(g, smem);
        g.A1 = Dp; g.A2 = Dp; g.lda1 = 512; g.lda2 = 512; g.ksplit = 512; g.Bt = W + OFF_POOL + i * SZ_POOL; g.K = 512;
        g.ntn = 2; g.mtiles = ctx_later ? 136 : 128; g.C = YP; g.ldc = 512;
        [[fallthrough]];
      case T_GEMM_BF16: gemm_phase<4, EPI_BF16>(g, smem); break;
      case T_SCAN:
        scan_phase(p, i, Rr, Kk, Vv, LO, LO + (size_t)MT * 512, LO + (size_t)2 * MT * 512, LO + (size_t)3 * MT * 512, Y0, Y1, smem);
        break;
      case T_MERGE:
        merge_phase(p, i, ctx_later ? MT : ML, Rr, Kk, Vv, LO + (size_t)2 * MT * 512, LO + (size_t)3 * MT * 512,
                    LO + (size_t)4 * MT * 512, Y0, Y1);
        break;
      case T_FFN: gemm_phase<4, EPI_FFN>(g, smem); break;
      case T_ODD: gemm_phase<3, EPI_ODD>(g, smem); break;
    }
    if (coop && (ph + 1 < ph_hi || rep + 1 < reps)) grid.sync();
    }
  }
}

extern "C" void kernel_launch(void* const* d_in, const int* in_sizes, int n_in, void* d_out, int out_size, void* d_ws,
                              size_t ws_size, hipStream_t stream) {
  Params p{};
  const float** pp = (const float**)&p;
  for (int k = 0; k < 28; ++k) pp[k] = (const float*)d_in[k];
  p.out = (float*)d_out;
  p.ws = (char*)d_ws;
  static int grid_blocks = 0;
  if (!grid_blocks) {
    int dev = 0, cus = 0, per_cu = 0;
    (void)hipGetDevice(&dev);
    (void)hipDeviceGetAttribute(&cus, hipDeviceAttributeMultiprocessorCount, dev);
    (void)hipOccupancyMaxActiveBlocksPerMultiprocessor(&per_cu, mega, NTHR, 0);
    if (per_cu > 1) per_cu = 1;
    if (per_cu < 1) per_cu = 1;
    grid_blocks = cus * per_cu;
    grid_blocks -= grid_blocks % 8;
  }
#if COOP
  int lo = 0, hi = NPHASES, coop = 1;
  void* args[] = {&p, &lo, &hi, &coop};
  hipError_t e = hipLaunchCooperativeKernel((void*)mega, dim3(grid_blocks), dim3(NTHR), args, 0, stream);
  if (e != hipSuccess) fprintf(stderr, "cooperative launch failed: %s (grid %d)\n", hipGetErrorString(e), grid_blocks);
#else
  for (int ph = 0; ph < NPHASES; ++ph) hipLaunchKernelGGL(mega, dim3(grid_blocks), dim3(NTHR), 0, stream, p, ph, ph + 1, 0);
#endif
}
```

```cpp
#include <hip/hip_runtime.h>
#include <hip/hip_bf16.h>
#include <hip/hip_cooperative_groups.h>
#include <cstdio>
namespace cg = cooperative_groups;

typedef unsigned short u16;
typedef _Float16 h16;
using bf16x8 = __attribute__((ext_vector_type(8))) short;
using f32x4 = __attribute__((ext_vector_type(4))) float;
typedef float f2 __attribute__((ext_vector_type(2)));
using h16x4 = __attribute__((ext_vector_type(4))) _Float16;
using u16x4 = __attribute__((ext_vector_type(4))) unsigned short;
using u16x8 = __attribute__((ext_vector_type(8))) unsigned short;

#ifndef REP_MASK
#define REP_MASK 0
#endif
#ifndef COOP
#define COOP 1
#endif

constexpr int D = 1024, NB = 8, SEQ = 4096, CTX = 256, DEPTH = 4;
constexpr int ML = NB * SEQ;
constexpr int MC = NB * CTX;
constexpr int MT = ML + MC;
constexpr int DFF = 2816;
constexpr int NEV = 2336, NEVP = 2560, DPROJ = 1824;
constexpr int NTHR = 512, NWV = 8;
constexpr int LORA_K = 384, LORA_N = 2560;
constexpr float RMS_EPS = 1e-6f, GN_EPS = 64e-5f;

constexpr size_t SZ_FFNUP = 5632ull * 1024, SZ_FFNDN = 1024ull * 2816, SZ_EVIN = 2560ull * 1024, SZ_SQ = 1024ull * 1024,
                 SZ_LORA = 2560ull * 384, SZ_POOL = 512ull * 512, SZ_ODIN = 3072ull * 1024;
constexpr size_t OFF_FFNUP = 0;
constexpr size_t OFF_FFNDN = OFF_FFNUP + 4 * SZ_FFNUP;
constexpr size_t OFF_EVIN = OFF_FFNDN + 4 * SZ_FFNDN;
constexpr size_t OFF_EVOUT = OFF_EVIN + 2 * SZ_EVIN;
constexpr size_t OFF_LORA = OFF_EVOUT + 2 * SZ_SQ;
constexpr size_t OFF_POOL = OFF_LORA + 2 * SZ_LORA;
constexpr size_t OFF_ODIN = OFF_POOL + 2 * SZ_POOL;
constexpr size_t OFF_ODOUT = OFF_ODIN + 2 * SZ_ODIN;
constexpr size_t W_ELEMS = OFF_ODOUT + 2 * SZ_SQ;
constexpr size_t B_MOD = W_ELEMS * 2;
constexpr size_t B_XC = B_MOD + 4ull * 9 * 6144 * 4;
constexpr size_t B_KINV = B_XC + (size_t)MC * D * 4;
constexpr size_t B_BAR = B_KINV + (size_t)MT * 8 * 4;
constexpr size_t B_ACT = B_BAR + 16384;
constexpr size_t UU = (size_t)MT * 512 * 2;
#define ACT(p, u) ((p).ws + B_ACT + (size_t)(u) * UU)

struct Params {
  const float *x, *c, *ctx, *c_ctx, *w_mod, *b_mod, *norm_g, *ffn_w_up, *ffn_conv, *ffn_w_down,
      *ev_w_in, *ev_w_out, *ev_mu, *ev_w0, *ev_w_up, *ev_a0, *ev_a_up, *ev_g_up, *ev_k_k, *ev_k_a, *ev_r_k,
      *ev_gn_w, *ev_gn_b, *ev_pool_w, *ev_pool_scale, *od_w_in, *od_conv, *od_w_out;
  float* out;
  char* ws;
};

__device__ __forceinline__ u16 f2bf(float f) {
  unsigned u = __float_as_uint(f);
  u += 0x7fffu + ((u >> 16) & 1u);
  return (u16)(u >> 16);
}
__device__ __forceinline__ float bf2f(u16 h) { return __uint_as_float(((unsigned)h) << 16); }
__device__ __forceinline__ float sigmoidf_(float x) { return __builtin_amdgcn_rcpf(1.f + __expf(-x)); }
__device__ __forceinline__ float siluf_(float x) { return x * __builtin_amdgcn_rcpf(1.f + __expf(-x)); }

template <int CTRL>
__device__ __forceinline__ float dppf(float x) {
  return __builtin_bit_cast(float, __builtin_amdgcn_update_dpp(0, __builtin_bit_cast(int, x), CTRL, 0xf, 0xf, true));
}
__device__ __forceinline__ float row16_sum(float x) {
  x += dppf<0x128>(x);
  x += dppf<0x124>(x);
  x += dppf<0x122>(x);
  x += dppf<0x121>(x);
  return x;
}
__device__ __forceinline__ float row16_transpose_sum(const float (&q)[16], int j16) {
  const bool b3 = (j16 & 8) != 0, b2 = (j16 & 4) != 0, b1 = (j16 & 2) != 0, b0 = (j16 & 1) != 0;
  float r1[8], r2[4], r3[2];
#pragma unroll
  for (int i = 0; i < 8; ++i) { float keep = b3 ? q[i + 8] : q[i], send = b3 ? q[i] : q[i + 8]; r1[i] = keep + dppf<0x140>(send); }
#pragma unroll
  for (int i = 0; i < 4; ++i) { float keep = b2 ? r1[i + 4] : r1[i], send = b2 ? r1[i] : r1[i + 4]; r2[i] = keep + dppf<0x141>(send); }
#pragma unroll
  for (int i = 0; i < 2; ++i) { float keep = b1 ? r2[i + 2] : r2[i], send = b1 ? r2[i] : r2[i + 2]; r3[i] = keep + dppf<0x1B>(send); }
  float keep = b0 ? r3[1] : r3[0], send = b0 ? r3[0] : r3[1];
  return keep + dppf<0xB1>(send);
}
__device__ __forceinline__ float wave_sum(float x) {
  x = row16_sum(x);
  x += __shfl_xor(x, 16);
  x += __shfl_xor(x, 32);
  return x;
}

__device__ __forceinline__ int opaque_tid() { int t = threadIdx.x; asm volatile("" : "+v"(t)); return t; }
__device__ __forceinline__ int opaque_bid() { int t = blockIdx.x; asm volatile("" : "+s"(t)); return t; }
__device__ __forceinline__ int vblock(int bid) { return (bid & 7) * (gridDim.x >> 3) + (bid >> 3); }

#define XB_TMO      128
#define XB_XCNT(j)  (256  + 64 * (j))
#define XB_XSUB(j)  (1280 + 64 * (j))
#define XB_XGEN(j)  (2304 + 64 * (j))
#define XB_TOP      3328
#define XB_TOPGEN   3392
#define XCD_BAR_WORDS 3456
#define XB_SPIN_CAP (1u << 18)
#define LAS __attribute__((address_space(3)))

__device__ __forceinline__ unsigned xb_ld(unsigned* p)              { return __hip_atomic_load(p, __ATOMIC_RELAXED, __HIP_MEMORY_SCOPE_AGENT); }
__device__ __forceinline__ unsigned xb_add(unsigned* p, unsigned v) { return __hip_atomic_fetch_add(p, v, __ATOMIC_RELAXED, __HIP_MEMORY_SCOPE_AGENT); }
__device__ __forceinline__ unsigned xb_xcc_id() { return (unsigned)__builtin_amdgcn_s_getreg((3 << 11) | 20) & 0xFu; }
#define XB_SPIN(cond, bar) do { unsigned _sp = 0; while (cond) { __builtin_amdgcn_s_sleep(1); \
    if ((++_sp & 255u) == 0u) { if (xb_ld(&(bar)[XB_TMO])) break; if (_sp > XB_SPIN_CAP) { atomicAdd(&(bar)[XB_TMO], 1u); break; } } } } while (0)

struct XcdBarrier {
    unsigned* bar; unsigned x;
    volatile LAS unsigned* st;
};

__device__ __forceinline__ XcdBarrier xcd_barrier_post(unsigned* bar, volatile LAS unsigned* st) {
    XcdBarrier b; b.bar = bar; b.x = xb_xcc_id(); b.st = st;
    if (threadIdx.x == 0) (void)xb_add(&bar[XB_XCNT(b.x)], 1u);
    return b;
}
__device__ __forceinline__ void xcd_barrier_complete(unsigned* bar, unsigned x, unsigned& nloc, unsigned& nx) {
    const unsigned G = gridDim.x * gridDim.y * gridDim.z;
    unsigned sum, cnt, mine, sp = 0u;
    for (;;) {
        sum = 0u; cnt = 0u; mine = 0u;
#pragma unroll
        for (unsigned j = 0; j < 16; ++j) { const unsigned c = xb_ld(&bar[XB_XCNT(j)]); sum += c; cnt += (c > 0u) ? 1u : 0u; mine = (j == x) ? c : mine; }
        if (sum == G) break;
        __builtin_amdgcn_s_sleep(1);
        if ((++sp & 255u) == 0u) { if (xb_ld(&bar[XB_TMO])) break; if (sp > XB_SPIN_CAP) { atomicAdd(&bar[XB_TMO], 1u); break; } }
    }
    nloc = mine > 0u ? mine : 1u; nx = cnt > 0u ? cnt : 1u;
}

__device__ __forceinline__ void xcd_barrier(const XcdBarrier& b) {
    asm volatile("s_waitcnt vmcnt(0)" ::: "memory");
    __syncthreads();
    if (threadIdx.x == 0) {
        unsigned* bar = b.bar;
        __builtin_amdgcn_s_waitcnt(0);
        unsigned nloc = b.st[0], nx = b.st[1];
        if (nloc == 0u) { xcd_barrier_complete(bar, b.x, nloc, nx); b.st[0] = nloc; b.st[1] = nx; }
        const unsigned old = xb_add(&bar[XB_XSUB(b.x)], 1u);
        const unsigned gen = old / nloc;
        if (old + 1u == (gen + 1u) * nloc) {
            __builtin_amdgcn_fence(__ATOMIC_RELEASE, "agent");
            asm volatile("s_waitcnt vmcnt(0)" ::: "memory");
            const unsigned og = xb_add(&bar[XB_TOP], 1u);
            const unsigned tg = og / nx;
            if (og + 1u == (tg + 1u) * nx) xb_add(&bar[XB_TOPGEN], 1u);
            else XB_SPIN(xb_ld(&bar[XB_TOPGEN]) == tg, bar);
            __builtin_amdgcn_fence(__ATOMIC_ACQUIRE, "agent");
            xb_add(&bar[XB_XGEN(b.x)], 1u);
            asm volatile("s_waitcnt vmcnt(0)" ::: "memory");
        } else {
            XB_SPIN(xb_ld(&bar[XB_XGEN(b.x)]) == gen, bar);
            __builtin_amdgcn_fence(__ATOMIC_ACQUIRE, "agent");
            asm volatile("s_waitcnt vmcnt(0)" ::: "memory");
        }
    }
    __syncthreads();
}

__device__ __forceinline__ int map_col(int kind, int nd, int srcN) {
  if (kind == 0) return nd < srcN ? nd : -1;
  if (kind == 3) {
    int t = nd >> 8, half = (nd >> 7) & 1, j = nd & 127;
    return half * DFF + t * 128 + j;
  }
  if (kind == 1) {
    int t = nd >> 7, r = nd & 127, wc = r >> 6, half = (r >> 5) & 1, j = r & 31;
    return half * DFF + t * 64 + wc * 32 + j;
  }
  int t = nd / 96, r = nd % 96, wc = r / 48, part = (r % 48) >> 4, j = r & 15;
  return part * 1024 + t * 32 + wc * 16 + j;
}

__device__ __forceinline__ size_t wt_off(int n, int k, int K, int BN) {
  int nb = n / BN, nr = n - nb * BN;
  int pos = ((k >> 3) & 7) ^ ((nr >> 1) & 7);
  return ((size_t)nb * (K >> 6) + (k >> 6)) * (size_t)(BN * 64) + nr * 64 + pos * 8 + (k & 7);
}

__device__ void conv_tile(const float* __restrict__ src, int srcN, int K, u16* __restrict__ dst, int kind, int tile,
                          int ntn64, float* sT, int tiledBN) {
  const int TIDX = opaque_tid(); const int BIDX = opaque_bid(); (void)TIDX; (void)BIDX;
  int tn = tile % ntn64, tk = tile / ntn64;
  int n0 = tn * 64, k0 = tk * 256;
  int tx = (TIDX & 15) * 4, ty = TIDX >> 4;
  int sc = map_col(kind, n0 + tx, srcN);
  float4 vals[8];
#pragma unroll
  for (int q = 0; q < 8; ++q)
    vals[q] = sc >= 0 ? *(const float4*)(src + (size_t)(k0 + ty + 32 * q) * srcN + sc) : float4{0.f, 0.f, 0.f, 0.f};
#pragma unroll
  for (int q = 0; q < 8; ++q) {
    float* d4 = sT + (ty + 32 * q) * 65 + tx;
    d4[0] = vals[q].x; d4[1] = vals[q].y; d4[2] = vals[q].z; d4[3] = vals[q].w;
  }
  __syncthreads();
  int n = TIDX >> 3;
#pragma unroll
  for (int jq = 0; jq < 4; ++jq) {
    int kq = (TIDX & 7) * 8 + 64 * jq;
    u16x8 o0;
#pragma unroll
    for (int e = 0; e < 8; ++e) o0[e] = f2bf(sT[(kq + e) * 65 + n]);
    u16* d = dst + (tiledBN ? wt_off(n0 + n, k0 + kq, K, tiledBN) : (size_t)(n0 + n) * K + k0 + kq);
    *(u16x8*)d = o0;
  }
  __syncthreads();
}

__device__ __forceinline__ void pre_phase(const Params& p, char* smem) {
  const int TIDX = opaque_tid(); const int BIDX = opaque_bid(); (void)TIDX; (void)BIDX;
  u16* W = (u16*)p.ws;
  float* sT = (float*)smem;
  constexpr int T_UP = 88 * 4, T_DN = 16 * 11, T_EVIN = 40 * 4, T_SQ = 64, T_ODIN = 48 * 4;
  constexpr int N_BIG = 4 * T_UP + 4 * T_DN + 2 * (T_EVIN + T_SQ + T_ODIN + T_SQ);
  constexpr int N_LORA = 240, N_POOL = 64;
  constexpr int N_SMALL = 2 * (N_LORA + N_POOL);
  constexpr int N_MOD = 4 * 96;
  constexpr int N_ALL = N_BIG + N_SMALL + N_MOD;
  for (int it = BIDX; it < N_ALL; it += gridDim.x) {
    if (it < N_MOD) {
      int l = it / 96, c0 = (it % 96) * 64;
      float* sS = (float*)smem;
      float* sR = sS + 9 * 1024;
      for (int e = TIDX; e < 9 * 1024; e += NTHR) {
        int j = e >> 10, k = e & 1023;
        float cv = j < 8 ? p.c[j * 1024 + k] : p.c_ctx[k];
        sS[e] = siluf_(cv);
      }
      __syncthreads();
      int w = TIDX >> 6, lane = TIDX & 63;
      float acc[9];
#pragma unroll
      for (int j = 0; j < 9; ++j) acc[j] = 0.f;
      const float* wm = p.w_mod + (size_t)l * 1024 * 6144 + c0 + lane;
#pragma unroll 8
      for (int k = w * 128; k < w * 128 + 128; ++k) {
        float wv = wm[(size_t)k * 6144];
#pragma unroll
        for (int j = 0; j < 9; ++j) acc[j] += sS[j * 1024 + k] * wv;
      }
#pragma unroll
      for (int j = 0; j < 9; ++j) sR[(w * 9 + j) * 64 + lane] = acc[j];
      __syncthreads();
      for (int e = TIDX; e < 9 * 64; e += NTHR) {
        int j = e >> 6, cc = e & 63;
        float s = 0.f;
#pragma unroll
        for (int ww = 0; ww < 8; ++ww) s += sR[(ww * 9 + j) * 64 + cc];
        s += p.b_mod[l * 6144 + c0 + cc];
        ((float*)(p.ws + B_MOD))[(size_t)(l * 9 + j) * 6144 + c0 + cc] = s;
      }
      __syncthreads();
      continue;
    }
    int t = it - N_MOD;
    if (t < N_BIG) {
      if (t < 4 * T_UP) {
        int l = t / T_UP;
        conv_tile(p.ffn_w_up + (size_t)l * 1024 * 5632, 5632, 1024, W + OFF_FFNUP + l * SZ_FFNUP, 3, t % T_UP, 88, sT, 0);
        continue;
      }
      t -= 4 * T_UP;
      if (t < 4 * T_DN) {
        int l = t / T_DN;
        conv_tile(p.ffn_w_down + (size_t)l * 2816 * 1024, 1024, 2816, W + OFF_FFNDN + l * SZ_FFNDN, 0, t % T_DN, 16, sT, 0);
        continue;
      }
      t -= 4 * T_DN;
      if (t < 2 * T_EVIN) {
        int i = t / T_EVIN;
        conv_tile(p.ev_w_in + (size_t)i * 1024 * NEV, NEV, 1024, W + OFF_EVIN + i * SZ_EVIN, 0, t % T_EVIN, 40, sT, 0);
        continue;
      }
      t -= 2 * T_EVIN;
      if (t < 2 * T_SQ) {
        int i = t / T_SQ;
        conv_tile(p.ev_w_out + (size_t)i * SZ_SQ, 1024, 1024, W + OFF_EVOUT + i * SZ_SQ, 0, t % T_SQ, 16, sT, 0);
        continue;
      }
      t -= 2 * T_SQ;
      if (t < 2 * T_ODIN) {
        int i = t / T_ODIN;
        conv_tile(p.od_w_in + (size_t)i * 1024 * 3072, 3072, 1024, W + OFF_ODIN + i * SZ_ODIN, 2, t % T_ODIN, 48, sT, 192);
        continue;
      }
      t -= 2 * T_ODIN;
      {
        int i = t / T_SQ;
        conv_tile(p.od_w_out + (size_t)i * SZ_SQ, 1024, 1024, W + OFF_ODOUT + i * SZ_SQ, 0, t % T_SQ, 16, sT, 0);
        continue;
      }
    }
    t -= N_BIG;
    {
      int i = t / (N_LORA + N_POOL);
      int r = t % (N_LORA + N_POOL);
      if (r < N_LORA) {
        u16* dst = W + OFF_LORA + i * SZ_LORA;
        for (int e = r * 4096 + TIDX; e < r * 4096 + 4096; e += NTHR) {
          const int e_K = LORA_K;
          int n = e / LORA_K, k = e % LORA_K;
          int seg = n >> 9, cc = n & 511;
          float v = 0.f;
          if (seg == 0) { if (k < 32) v = p.ev_w_up[((size_t)(i * 2 + 0) * 32 + k) * 512 + cc]; }
          else if (seg == 1) { if (k >= 32 && k < 64) v = p.ev_w_up[((size_t)(i * 2 + 1) * 32 + (k - 32)) * 512 + cc]; }
          else if (seg == 2) { if (k >= 64 && k < 128) v = p.ev_a_up[((size_t)(i * 2 + 0) * 64 + (k - 64)) * 512 + cc]; }
          else if (seg == 3) { if (k >= 128 && k < 192) v = p.ev_a_up[((size_t)(i * 2 + 1) * 64 + (k - 128)) * 512 + cc]; }
          else { if (k >= 192 && k < 288) v = p.ev_g_up[((size_t)i * 96 + (k - 192)) * 512 + cc]; }
          dst[wt_off(n, k, e_K, 256)] = f2bf(v);
        }
      } else {
        r -= N_LORA;
        u16* dst = W + OFF_POOL + i * SZ_POOL;
        for (int e = r * 4096 + TIDX; e < r * 4096 + 4096; e += NTHR) {
          int n = e >> 9, k = e & 511;
          float v = 0.f;
          int g = n >> 7;
          if ((k >> 7) == g) v = p.ev_pool_w[(((size_t)i * 4 + g) * 128 + (k & 127)) * 128 + (n & 127)] * p.ev_pool_scale[i * 512 + n];
          dst[e] = f2bf(v);
        }
      }
    }
  }
}

__device__ __forceinline__ void row_phase(const Params& p, const bool HAS_Y, const bool HAS_H, int nrows, const u16* __restrict__ Y,
                          const float* __restrict__ modg  , int gate_chunk, const float* __restrict__ gy,
                          const float* __restrict__ gx, const float* __restrict__ modh  , int shift_chunk,
                          u16* __restrict__ H, const bool x_in  ) {
  const int TIDX = opaque_tid(); const int BIDX = opaque_bid();
  const int lane = TIDX & 63;
  const int gw = BIDX * NWV + (TIDX >> 6), nw = gridDim.x * NWV;
  const int rpw = (nrows + nw - 1) / nw;
  const int r_begin = gw * rpw, r_end = min(r_begin + rpw, nrows);
  float* XC = (float*)(p.ws + B_XC);
  float4 gyv[4], gxv[4], gtv[4], shv[4], scv[4];
#pragma unroll
  for (int i = 0; i < 4; ++i) {
    gyv[i] = HAS_Y ? *(const float4*)(gy + i * 256 + lane * 4) : float4{0.f, 0.f, 0.f, 0.f};
    gxv[i] = HAS_H ? *(const float4*)(gx + i * 256 + lane * 4) : float4{0.f, 0.f, 0.f, 0.f};
    gtv[i] = shv[i] = scv[i] = float4{0.f, 0.f, 0.f, 0.f};
  }
  int bcur = -1;
#pragma unroll 1
  for (int row = r_begin; row < r_end; ++row) {
    const int b = row < ML ? (row >> 12) : 8;
    if (b != bcur) {
      bcur = b;
#pragma unroll
      for (int i = 0; i < 4; ++i) {
        const int c = i * 256 + lane * 4;
        if (HAS_Y) gtv[i] = *(const float4*)(modg + (size_t)b * 6144 + gate_chunk * 1024 + c);
        if (HAS_H) {
          shv[i] = *(const float4*)(modh + (size_t)b * 6144 + shift_chunk * 1024 + c);
          scv[i] = *(const float4*)(modh + (size_t)b * 6144 + (shift_chunk + 1) * 1024 + c);
        }
      }
    }
    float* xr = row < ML ? p.out + (size_t)row * D : XC + (size_t)(row - ML) * D;
    float4 xv[4];
    const float* xsrc = x_in ? (row < ML ? p.x + (size_t)row * D : p.ctx + (size_t)(row - ML) * D) : xr;
    if (HAS_Y) {
#pragma unroll
      for (int i = 0; i < 4; ++i) xv[i] = *(const float4*)(xsrc + i * 256 + lane * 4);
      float yv[16];
      float ss = 0.f;
#pragma unroll
      for (int i = 0; i < 4; ++i) {
        u16x4 t = *(const u16x4*)(Y + (size_t)row * D + i * 256 + lane * 4);
#pragma unroll
        for (int e = 0; e < 4; ++e) { yv[i * 4 + e] = bf2f(t[e]); ss += yv[i * 4 + e] * yv[i * 4 + e]; }
      }
      ss = wave_sum(ss);
      float rstd = rsqrtf(ss * (1.f / D) + RMS_EPS);
#pragma unroll
      for (int i = 0; i < 4; ++i) {
        xv[i].x += gtv[i].x * (yv[i * 4 + 0] * rstd * gyv[i].x);
        xv[i].y += gtv[i].y * (yv[i * 4 + 1] * rstd * gyv[i].y);
        xv[i].z += gtv[i].z * (yv[i * 4 + 2] * rstd * gyv[i].z);
        xv[i].w += gtv[i].w * (yv[i * 4 + 3] * rstd * gyv[i].w);
      }
    } else {
      const float* src = row < ML ? p.x + (size_t)row * D : p.ctx + (size_t)(row - ML) * D;
#pragma unroll
      for (int i = 0; i < 4; ++i) xv[i] = *(const float4*)(src + i * 256 + lane * 4);
    }
    if (HAS_Y) {
#pragma unroll
      for (int i = 0; i < 4; ++i) *(float4*)(xr + i * 256 + lane * 4) = xv[i];
    }
    if (HAS_H) {
      float ss = 0.f;
#pragma unroll
      for (int i = 0; i < 4; ++i) ss += xv[i].x * xv[i].x + xv[i].y * xv[i].y + xv[i].z * xv[i].z + xv[i].w * xv[i].w;
      ss = wave_sum(ss);
      float rstd = rsqrtf(ss * (1.f / D) + RMS_EPS);
#pragma unroll
      for (int i = 0; i < 4; ++i) {
        u16x4 o;
        o[0] = f2bf(xv[i].x * rstd * gxv[i].x * (1.f + scv[i].x) + shv[i].x);
        o[1] = f2bf(xv[i].y * rstd * gxv[i].y * (1.f + scv[i].y) + shv[i].y);
        o[2] = f2bf(xv[i].z * rstd * gxv[i].z * (1.f + scv[i].z) + shv[i].z);
        o[3] = f2bf(xv[i].w * rstd * gxv[i].w * (1.f + scv[i].w) + shv[i].w);
        *(u16x4*)(H + (size_t)row * D + i * 256 + lane * 4) = o;
      }
    }
  }
}

namespace pg8 {
#define PG8_LAS __attribute__((address_space(3)))
typedef unsigned short bf16_t;
typedef short bf16x8 __attribute__((ext_vector_type(8)));
typedef float f32x4 __attribute__((ext_vector_type(4)));
typedef unsigned u32x4 __attribute__((ext_vector_type(4)));
constexpr int BM = 256, BK = 64, HALF = 128, HTB = HALF * BK * 2  , STAGE_BYTES = 8 * HTB, NXCD = 8, WGM = 8;

__host__ __device__ __forceinline__ int lds_byte(int r, int c) { const int st = (r >> 4) * 2 + (c >> 5), rr = r & 15, cc = c & 31, ob = rr * 64 + cc * 2; return st * 1024 + (ob ^ (((ob >> 9) & 1) << 5)); }
__host__ __device__ __forceinline__ void stage_rc(int b, int& R, int& C) { const int st = b / 1024, sb = b % 1024, swz = sb ^ (((sb >> 9) & 1) << 5); R = (st >> 1) * 16 + swz / 64; C = (st & 1) * 32 + (swz % 64) / 2; }
__host__ __device__ __forceinline__ int perm32(int rho) { const int n = rho >> 4, i = rho & 15; return 8 * (i >> 2) + 4 * n + (i & 3); }

struct Unit { int pm, pn; };
struct Gemm { const bf16_t* A; const bf16_t* Bt; int M, N, K; };
__device__ __forceinline__ unsigned cvt_pk_bf16(float lo, float hi) { unsigned r; asm volatile("v_cvt_pk_bf16_f32 %0, %1, %2" : "=v"(r) : "v"(lo), "v"(hi)); return r; }
struct TileOrder {
  int ntn, ntiles, G, vb;
  __device__ __forceinline__ bool next(int i, Unit& u) const {
    const int tile = vb + i * G;
    if (tile >= ntiles) return false;
    const int grp = tile / (8 * ntn), rem = tile - grp * 8 * ntn;
    u.pn = rem >> 3; u.pm = grp * 8 + (rem & 7);
    return true;
  }
  __device__ __forceinline__ void a_ready(const Unit&) const {}
  __device__ __forceinline__ void done(const Unit&) const {}
};
struct EpiStoreBf16 {
  static constexpr bool PERM = true, AFTER_DRAIN = false;
  bf16_t* O; int ldc;
  __device__ __forceinline__ void operator()(const f32x4 (&acc)[2][2][4][2], const Unit& u, int wr, int wc, int fr, int fq) const {
    const int row0 = u.pm * BM + wr * 64 + fr, col0 = u.pn * BM + wc * 32 + 8 * fq;
#pragma unroll
    for (int ai = 0; ai < 2; ++ai)
#pragma unroll
      for (int m = 0; m < 4; ++m) {
        bf16_t* rowp = O + (size_t)(row0 + ai * HALF + m * 16) * ldc + col0;
#pragma unroll
        for (int bj = 0; bj < 2; ++bj) {
          const f32x4 v0 = acc[ai][bj][m][0], v1 = acc[ai][bj][m][1];
          u32x4 w; w.x = cvt_pk_bf16(v0[0], v0[1]); w.y = cvt_pk_bf16(v0[2], v0[3]); w.z = cvt_pk_bf16(v1[0], v1[1]); w.w = cvt_pk_bf16(v1[2], v1[3]);
          *(u32x4*)(rowp + bj * HALF) = w;
        }
      }
  }
};
struct EpiFfnConv {
  static constexpr bool PERM = true, AFTER_DRAIN = false;
  bf16_t* O; const float* cw; PG8_LAS float* X;
  __device__ __forceinline__ void operator()(const f32x4 (&acc)[2][2][4][2], const Unit& u, int wr, int wc, int fr, int fq) const {
    const int chl = 32 * wc + 8 * fq, ch0 = u.pn * 128 + chl;
    f32x4 w0[2], w1[2], w2[2];
#pragma unroll
    for (int n = 0; n < 2; ++n) {
      w0[n] = *(const f32x4*)(cw + ch0 + 4 * n); w1[n] = *(const f32x4*)(cw + DFF + ch0 + 4 * n); w2[n] = *(const f32x4*)(cw + 2 * DFF + ch0 + 4 * n);
    }
    const bool ctx = u.pm >= ML / 256;
    if (ctx) {
#pragma unroll
      for (int ai = 0; ai < 2; ++ai) {
        const int bnd = 2 * ai + wr;
        const int dump = 1024 + (fq * 16 + fr) * 8;
        const int a_first = (fr == 0) ? (bnd * 2 + 0) * 128 + chl : dump;
        const int a_last = (fr == 15) ? (bnd * 2 + 1) * 128 + chl : dump;
        *(PG8_LAS f32x4*)(X + a_first) = acc[ai][0][0][0]; *(PG8_LAS f32x4*)(X + a_first + 4) = acc[ai][0][0][1];
        *(PG8_LAS f32x4*)(X + a_last) = acc[ai][0][3][0]; *(PG8_LAS f32x4*)(X + a_last + 4) = acc[ai][0][3][1];
      }
      asm volatile("s_waitcnt lgkmcnt(0)" ::: "memory");
      __builtin_amdgcn_s_barrier();
      __builtin_amdgcn_s_barrier();
    }
#pragma unroll
    for (int ai = 0; ai < 2; ++ai) {
      const int bnd = 2 * ai + wr;
      f32x4 ep[2], en[2];
#pragma unroll
      for (int n = 0; n < 2; ++n) { ep[n] = (f32x4){0.f, 0.f, 0.f, 0.f}; en[n] = (f32x4){0.f, 0.f, 0.f, 0.f}; }
      if (ctx) {
        if (bnd > 0) { ep[0] = *(const PG8_LAS f32x4*)(X + ((bnd - 1) * 2 + 1) * 128 + chl); ep[1] = *(const PG8_LAS f32x4*)(X + ((bnd - 1) * 2 + 1) * 128 + chl + 4); }
        if (bnd < 3) { en[0] = *(const PG8_LAS f32x4*)(X + ((bnd + 1) * 2 + 0) * 128 + chl); en[1] = *(const PG8_LAS f32x4*)(X + ((bnd + 1) * 2 + 0) * 128 + chl + 4); }
      }
#pragma unroll
      for (int m = 0; m < 4; ++m) {
        float o[8];
#pragma unroll
        for (int n = 0; n < 2; ++n)
#pragma unroll
          for (int e = 0; e < 4; ++e) {
            const float a = acc[ai][0][m][n][e];
            const float up = (m > 0) ? acc[ai][0][m > 0 ? m - 1 : 0][n][e] : ep[n][e];
            const float dn = (m < 3) ? acc[ai][0][m < 3 ? m + 1 : 3][n][e] : en[n][e];
            const float pv = dppf<0x121>(fr == 15 ? up : a);
            const float nv = dppf<0x12F>(fr == 0 ? dn : a);
            const float cv = w0[n][e] * pv + w1[n][e] * a + w2[n][e] * nv;
            o[n * 4 + e] = siluf_(cv) * acc[ai][1][m][n][e];
          }
        u32x4 w; w.x = cvt_pk_bf16(o[0], o[1]); w.y = cvt_pk_bf16(o[2], o[3]); w.z = cvt_pk_bf16(o[4], o[5]); w.w = cvt_pk_bf16(o[6], o[7]);
        *(u32x4*)(O + (size_t)(u.pm * BM + ai * HALF + wr * 64 + m * 16 + fr) * DFF + ch0) = w;
      }
    }
  }
};
template <class Epi, class Sched, bool STAMP = false>
__device__ __forceinline__ void gemm_phase(PG8_LAS unsigned char* lds, const Gemm g, const Sched& S, const Epi& E, unsigned long long* stamps) {
    const int tid = opaque_tid(), wid = __builtin_amdgcn_readfirstlane(tid >> 6), lane = tid & 63, wr = wid >> 2, wc = wid & 3, fr = lane & 15, fq = lane >> 4;
    const int K = g.K, nt = K / BK;
    int ts_lo = 0, ts_hi = 0, nts = 0; const unsigned long long rt_entry = STAMP ? (unsigned long long)0 : 0ull;
#define PG8_STAMP() do { if (STAMP && wid == 0 && nts < 64) { const unsigned long long _c = (unsigned long long)clock64(); \
        ts_lo = (lane == nts) ? (int)(unsigned)_c : ts_lo; ts_hi = (lane == nts) ? (int)(unsigned)(_c >> 32) : ts_hi; ++nts; } } while (0)
    PG8_STAMP();
    unsigned voffA[2], voffB[2];
#pragma unroll
    for (int i = 0; i < 2; ++i) { int R, C; stage_rc(tid * 16 + i * 8192, R, C); const int Rb = Epi::PERM ? ((R & ~31) + perm32(R & 31)) : R;
        voffA[i] = (unsigned)(R * K + C) * 2u; voffB[i] = (unsigned)(Rb * K + C) * 2u; }
    const size_t kstep = (size_t)(BK * 2);
    const size_t hstep = (size_t)HALF * K * 2;
    const size_t tstep = 2 * hstep;
    const unsigned ldsw = (unsigned)wid * 1024u;
    const int aoff = lds_byte(wr * 64 + fr, fq * 8), boff = lds_byte(wc * 32 + fr, fq * 8);
#define PG8_SA(b, h) (((b) * 2 + (h)) * HTB)
#define PG8_SB(b, h) ((4 + (b) * 2 + (h)) * HTB)
#define PG8_STAGE(bufoff, gbase, voff) do { _Pragma("unroll") for (int _i = 0; _i < 2; ++_i) \
        __builtin_amdgcn_global_load_lds((const unsigned*)((const char*)(gbase) + (voff)[_i]), (PG8_LAS unsigned*)(lds + (bufoff) + ldsw + _i * 8192), 16, 0, 0); } while (0)
#define PG8_LDA(dst, b, h) do { _Pragma("unroll") for (int m = 0; m < 4; ++m) _Pragma("unroll") for (int k = 0; k < 2; ++k) dst[m][k] = *(const PG8_LAS bf16x8*)(lds + PG8_SA(b, h) + aoff + m * 2048 + k * 1024); } while (0)
#define PG8_LDB(dst, b, h) do { _Pragma("unroll") for (int n = 0; n < 2; ++n) _Pragma("unroll") for (int k = 0; k < 2; ++k) dst[n][k] = *(const PG8_LAS bf16x8*)(lds + PG8_SB(b, h) + boff + n * 2048 + k * 1024); } while (0)
#define PG8_MMA(ai, bj, At, Bt) do { __builtin_amdgcn_s_setprio(1); _Pragma("unroll") for (int m = 0; m < 4; ++m) _Pragma("unroll") for (int n = 0; n < 2; ++n) _Pragma("unroll") for (int k = 0; k < 2; ++k) \
        acc[ai][bj][m][n] = __builtin_amdgcn_mfma_f32_16x16x32_bf16(Bt[n][k], At[m][k], acc[ai][bj][m][n], 0, 0, 0); __builtin_amdgcn_s_setprio(0); } while (0)
#define PG8_WAIT_V(n) asm volatile("s_waitcnt vmcnt(" #n ")" ::: "memory")
#define PG8_WAIT_L(n) asm volatile("s_waitcnt lgkmcnt(" #n ")" ::: "memory")
#define PG8_BAR __builtin_amdgcn_s_barrier()
#define PG8_SCHED __builtin_amdgcn_sched_barrier(0)
    Unit cur, nxt; int ui = 0;
    if (!S.next(0, cur)) return;
    f32x4 acc[2][2][4][2];
#pragma unroll
    for (int a = 0; a < 2; ++a)
#pragma unroll
        for (int b = 0; b < 2; ++b)
#pragma unroll
            for (int m = 0; m < 4; ++m)
#pragma unroll
                for (int n = 0; n < 2; ++n) acc[a][b][m][n] = (f32x4){0.f, 0.f, 0.f, 0.f};
    bf16x8 At[4][2], B0[2][2], B1[2][2];
    const char* cA = (const char*)g.A + (size_t)cur.pm * tstep; const char* cB = (const char*)g.Bt + (size_t)cur.pn * tstep;
    S.a_ready(cur);
    PG8_STAGE(PG8_SB(0, 0), cB, voffB); PG8_STAGE(PG8_SA(0, 0), cA, voffA); PG8_STAGE(PG8_SB(0, 1), cB + hstep, voffB); PG8_STAGE(PG8_SA(0, 1), cA + hstep, voffA);
    if (wr == 1) PG8_BAR;
    PG8_WAIT_V(4); PG8_BAR;
    PG8_STAGE(PG8_SB(1, 0), cB + kstep, voffB); PG8_STAGE(PG8_SA(1, 0), cA + kstep, voffA); PG8_STAGE(PG8_SB(1, 1), cB + hstep + kstep, voffB);
    PG8_WAIT_V(6); PG8_BAR;
    PG8_STAMP();
    for (;;) {
        const bool has_next = S.next(ui + 1, nxt);
        const char* nA = has_next ? (const char*)g.A + (size_t)nxt.pm * tstep : cA; const char* nB = has_next ? (const char*)g.Bt + (size_t)nxt.pn * tstep : cB;
        for (int t = 0; t < nt; t += 2) {
            const bool last = (t == nt - 2);
            const char* a1 = cA + (size_t)(t + 1) * kstep;
            const char* a2 = last ? nA : cA + (size_t)(t + 2) * kstep; const char* b2 = last ? nB : cB + (size_t)(t + 2) * kstep;
            const char* a3 = a2 + kstep; const char* b3 = b2 + kstep;
            if (last && has_next) S.a_ready(nxt);
            PG8_LDB(B0, 0, 0); PG8_SCHED; PG8_LDA(At, 0, 0); PG8_STAGE(PG8_SA(1, 1), a1 + hstep, voffA);
            PG8_WAIT_L(8); PG8_BAR; PG8_WAIT_L(0); PG8_MMA(0, 0, At, B0); PG8_BAR; PG8_SCHED;
            PG8_LDB(B1, 0, 1); PG8_STAGE(PG8_SB(0, 0), b2, voffB);
            PG8_BAR; PG8_WAIT_L(0); PG8_MMA(0, 1, At, B1); PG8_BAR;
            PG8_LDA(At, 0, 1); PG8_STAGE(PG8_SA(0, 0), a2, voffA);
            PG8_BAR; PG8_WAIT_L(0); PG8_MMA(1, 0, At, B0); PG8_BAR; PG8_SCHED;
            PG8_STAGE(PG8_SB(0, 1), b2 + hstep, voffB);
            PG8_WAIT_V(6); PG8_BAR; PG8_MMA(1, 1, At, B1); PG8_BAR;
            PG8_LDB(B0, 1, 0); PG8_SCHED; PG8_LDA(At, 1, 0); PG8_STAGE(PG8_SA(0, 1), a2 + hstep, voffA);
            PG8_WAIT_L(8); PG8_BAR; PG8_WAIT_L(0); PG8_MMA(0, 0, At, B0); PG8_BAR; PG8_SCHED;
            PG8_LDB(B1, 1, 1); PG8_STAGE(PG8_SB(1, 0), b3, voffB);
            PG8_BAR; PG8_WAIT_L(0); PG8_MMA(0, 1, At, B1); PG8_BAR;
            PG8_LDA(At, 1, 1); PG8_STAGE(PG8_SA(1, 0), a3, voffA);
            PG8_BAR; PG8_WAIT_L(0); PG8_MMA(1, 0, At, B0); PG8_BAR; PG8_SCHED;
            PG8_STAGE(PG8_SB(1, 1), b3 + hstep, voffB);
            PG8_WAIT_V(6); PG8_BAR; PG8_MMA(1, 1, At, B1); PG8_BAR;
        }
        PG8_STAMP();
        if constexpr (!Epi::AFTER_DRAIN) { E(acc, cur, wr, wc, fr, fq); S.done(cur); }
        PG8_STAMP();
        if (!has_next) break;
#pragma unroll
        for (int a = 0; a < 2; ++a)
#pragma unroll
            for (int b = 0; b < 2; ++b)
#pragma unroll
                for (int m = 0; m < 4; ++m)
#pragma unroll
                    for (int n = 0; n < 2; ++n) acc[a][b][m][n] = (f32x4){0.f, 0.f, 0.f, 0.f};
        cur = nxt; cA = nA; cB = nB; ++ui;
    }
    PG8_WAIT_V(0);
    if (wr == 0) PG8_BAR;
    PG8_BAR;
    if constexpr (Epi::AFTER_DRAIN) { E.fused(acc, cur, wr, wc, fr, fq, lds, wid, lane); S.done(cur); }
    PG8_STAMP();
    if (STAMP && wid == 0) { stamps[lane] = lane < nts ? (((unsigned long long)(unsigned)ts_hi << 32) | (unsigned)ts_lo) : 0ull;
        if (lane == 62) stamps[62] = rt_entry; if (lane == 63) stamps[63] = (unsigned long long)0; }
#undef PG8_STAMP
#undef PG8_SA
#undef PG8_SB
#undef PG8_STAGE
#undef PG8_LDA
#undef PG8_LDB
#undef PG8_MMA
#undef PG8_WAIT_V
#undef PG8_WAIT_L
#undef PG8_BAR
#undef PG8_SCHED
}
}

enum { EPI_BF16 = 0, EPI_FFN = 1, EPI_ODD = 2, EPI_LORA = 3 };

struct GemmP {
  const u16* A1; const u16* A2; int lda1, lda2, ksplit;
  const u16* Bt; int K; int ntn; int mtiles; int conv;
  u16* C; int ldc;
  const float* cw;
  int cwC;
  const float* w0; const float* a0; h16* lout;
};

__device__ __forceinline__ bool seg_start(int a) { return a < ML ? ((a & 63) == 0) : (((a - ML) & 255) == 0); }
__device__ __forceinline__ bool seg_end(int a) { return a < ML ? ((a & 63) == 63) : (((a - ML) & 255) == 255); }

#define RAW_BARRIER() do { asm volatile("s_waitcnt lgkmcnt(0)" ::: "memory"); __builtin_amdgcn_s_barrier(); } while (0)
constexpr int GSTAGE = 65536;
constexpr int NSTG = 2;
constexpr int SMEM_BYTES = NSTG * GSTAGE;

template <int NT, int EPI>
__device__ __forceinline__ void gemm_phase(const GemmP& g, char* smem) {
  const int TIDX = opaque_tid(); const int BIDX = opaque_bid(); (void)TIDX; (void)BIDX;
  constexpr int BN = 64 * NT;
  const int tid = TIDX, wid = tid >> 6, lane = tid & 63, wr = wid >> 2, wc = wid & 3, fr = lane & 15, fq = lane >> 4;
  const int ntiles = g.mtiles * g.ntn;
  const int sr = tid >> 3;
  const int scol = ((tid & 7) ^ ((sr >> 1) & 7)) * 8;
  const int sw0 = ((fq) ^ (fr >> 1)) * 8, sw1 = ((4 + fq) ^ (fr >> 1)) * 8;
#pragma unroll 1
  for (int tile = vblock(BIDX); tile < ntiles; tile += gridDim.x) {
    int grp_ = tile / (8 * g.ntn), rem_ = tile - grp_ * 8 * g.ntn;
    int nt = rem_ >> 3, mt = grp_ * 8 + (rem_ & 7);
    const int row0 = mt * 256;
    const int n0 = nt * BN;
    f32x4 acc[8][NT];
#pragma unroll
    for (int m = 0; m < 8; ++m)
#pragma unroll
      for (int n = 0; n < NT; ++n) acc[m][n] = f32x4{0.f, 0.f, 0.f, 0.f};
    const int kt0 = (EPI == EPI_LORA) ? (nt < 4 ? 0 : (nt < 8 ? 1 : 3)) : 0;
    const int nk = (EPI == EPI_LORA) ? (nt < 4 ? 1 : 2) : (g.K >> 6);
    const u16* bbase = g.Bt + (size_t)nt * (g.K >> 6) * (BN * 64) + tid * 8;
    auto piece = [&](int t, int st, int q) {
      char* base = smem + st * GSTAGE + tid * 16;
      t += kt0;
      int kk = t << 6;
      if (q < 4) {
        const u16* Ab; int lda;
        if (kk < g.ksplit) { Ab = g.A1 + kk; lda = g.lda1; } else { Ab = g.A2 + (kk - g.ksplit); lda = g.lda2; }
        const u16* ap = Ab + (size_t)(row0 + sr + 64 * q) * lda + scol;
        __builtin_amdgcn_global_load_lds((const unsigned*)(ap), (unsigned*)(base + q * 8192), 16, 0, 0);
      } else {
        const int qq = (NT == 3 && q == 7) ? 2 : q - 4;
        __builtin_amdgcn_global_load_lds((const unsigned*)(bbase + (size_t)t * (BN * 64) + qq * 4096), (unsigned*)(base + 32768 + (q - 4) * 8192), 16, 0, 0);
      }
    };
    auto issue = [&](int t, int st) {
#pragma unroll
      for (int q = 0; q < 8; ++q) piece(t, st, q);
    };
    issue(0, 0);
#pragma unroll 1
    for (int t = 0; t < nk; ++t) {
      const int st = t & 1;
      asm volatile("s_waitcnt vmcnt(0)" ::: "memory");
      RAW_BARRIER();
      const bool more = t + 1 < nk;
      const u16* SA = (const u16*)(smem + st * GSTAGE);
      const u16* SB = (const u16*)(smem + st * GSTAGE + 32768);
      const u16* pa = SA + (wr * 128 + fr) * 64;
      const u16* pb = SB + (wc * 16 * NT + fr) * 64;
      bf16x8 Ac[4], An[4], Bc[NT], Bn[NT];
#pragma unroll
      for (int n = 0; n < NT; ++n) Bc[n] = *(const bf16x8*)(pb + n * 16 * 64 + sw0);
#pragma unroll
      for (int m = 0; m < 4; ++m) Ac[m] = *(const bf16x8*)(pa + m * 16 * 64 + sw0);
#pragma unroll
      for (int u = 0; u < 4; ++u) {
        const int mh = u & 1;
        if (u < 3) {
          const int nmh = (u + 1) & 1, nsw = ((u + 1) >> 1) ? sw1 : sw0;
#pragma unroll
          for (int m = 0; m < 4; ++m) An[m] = *(const bf16x8*)(pa + (nmh * 64 + m * 16) * 64 + nsw);
        }
        if (u == 1) {
#pragma unroll
          for (int n = 0; n < NT; ++n) Bn[n] = *(const bf16x8*)(pb + n * 16 * 64 + sw1);
        }
#pragma unroll
        for (int m = 0; m < 4; ++m) {
#pragma unroll
          for (int n = 0; n < NT; ++n)
            acc[mh * 4 + m][n] = __builtin_amdgcn_mfma_f32_16x16x32_bf16(Ac[m], Bc[n], acc[mh * 4 + m][n], 0, 0, 0);
          if (u < 2) {
            if (more) piece(t + 1, st ^ 1, u * 4 + m);
          }
        }
        if (u < 3) {
#pragma unroll
          for (int m = 0; m < 4; ++m) Ac[m] = An[m];
        }
        if (u == 1) {
#pragma unroll
          for (int n = 0; n < NT; ++n) Bc[n] = Bn[n];
        }
      }
    }
    __syncthreads();
    if (EPI == EPI_BF16) {
#pragma unroll
      for (int m = 0; m < 8; ++m)
#pragma unroll
        for (int j = 0; j < 4; ++j) {
          int r = wr * 128 + m * 16 + fq * 4 + j;
          size_t ro = (size_t)(row0 + r) * g.ldc + n0 + wc * 16 * NT + fr;
#pragma unroll
          for (int n = 0; n < NT; ++n) g.C[ro + n * 16] = f2bf(acc[m][n][j]);
        }
    } else if (EPI == EPI_LORA) {
      const int seg = n0 >> 9;
      h16* dst = g.lout + (size_t)seg * MT * 512 + (size_t)row0 * 512 + (n0 & 511) + wc * 16 * NT + fr;
      float bias[NT];
#pragma unroll
      for (int n = 0; n < NT; ++n) {
        int cc = (n0 & 511) + wc * 16 * NT + n * 16 + fr;
        bias[n] = seg < 2 ? g.w0[seg * 512 + cc] : (seg < 4 ? g.a0[(seg - 2) * 512 + cc] : 0.f);
      }
      const bool odd = (fr & 1) != 0;
      auto lora_store = [&](auto fn) {
        unsigned ro = (unsigned)(wr * 128 + fq * 4) * 512;
#pragma unroll
        for (int m = 0; m < 8; ++m) {
          asm volatile("" : "+v"(ro));
#pragma unroll
          for (int n = 0; n < NT; ++n)
#pragma unroll
            for (int jp = 0; jp < 2; ++jp) {
              const float va = fn(acc[m][n][2 * jp] + bias[n]), vb2 = fn(acc[m][n][2 * jp + 1] + bias[n]);
              const float recv = dppf<0xB1>(odd ? va : vb2);
              const h16 lo = (h16)(odd ? recv : va), hi = (h16)(odd ? vb2 : recv);
              const unsigned pk = (unsigned)__builtin_bit_cast(unsigned short, lo) | ((unsigned)__builtin_bit_cast(unsigned short, hi) << 16);
              *(unsigned*)(dst + ro + (2 * jp + (odd ? 1 : 0)) * 512 + n * 16 - (odd ? 1 : 0)) = pk;
            }
          ro += 16 * 512;
          __syncthreads();
        }
      };
      if (seg < 2) {
        lora_store([](float v) { return -0.60653066f * sigmoidf_(v); });
      } else if (seg < 4) {
        lora_store([](float v) { return sigmoidf_(v); });
      } else {
        lora_store([](float v) { return v; });
      }
    } else {
      constexpr int CW = (EPI == EPI_FFN) ? 128 : 64;
      constexpr int CPW = CW / 4;
      constexpr int NA = CPW / 16;
      float* sC = (float*)smem;
      constexpr int LDC = (EPI == EPI_FFN) ? DFF : D;
      const int colofs = wc * CPW + fr;
      {
        float* sb = sC + (wr * 128 + fq * 4) * CW + colofs;
#pragma unroll
        for (int m = 0; m < 8; ++m)
#pragma unroll
          for (int n = 0; n < NA; ++n)
#pragma unroll
            for (int j = 0; j < 4; j += 3) {
              float u = (EPI == EPI_FFN) ? acc[m][n][j] : acc[m][1][j] * acc[m][2][j];
              sb[(m * 16 + j) * CW + n * 16] = u;
            }
      }
      __syncthreads();
      float cwv[NA][3];
#pragma unroll
      for (int n = 0; n < NA; ++n) {
        int ch = nt * CW + colofs + n * 16;
        cwv[n][0] = g.cw[ch]; cwv[n][1] = g.cw[g.cwC + ch]; cwv[n][2] = g.cw[2 * g.cwC + ch];
      }
      const bool lat = row0 < ML;
      const int segmask = lat ? 63 : 255;
      u16* const sO = (u16*)(smem + GSTAGE);
      int rb = wr * 128 + fq * 4;
#pragma unroll
      for (int m = 0; m < 8; ++m) {
        asm volatile("" : "+v"(rb));
        const int so = rb * CW + colofs;
#pragma unroll
        for (int n = 0; n < NA; ++n) {
          float c4[4];
#pragma unroll
          for (int j = 0; j < 4; ++j) c4[j] = (EPI == EPI_FFN) ? acc[m][n][j] : acc[m][1][j] * acc[m][2][j];
          const float pv0 = sC[max(so - CW, 0) + n * 16];
          const float nv3 = sC[min(so + 4 * CW, 255 * CW + colofs) + n * 16];
#pragma unroll
          for (int j = 0; j < 4; ++j) {
            const int r = rb + j;
            float pv = (j == 0) ? pv0 : c4[j - 1];
            float nv = (j == 3) ? nv3 : c4[j + 1];
            pv = ((r & segmask) == 0) ? 0.f : pv;
            nv = ((r & segmask) == segmask) ? 0.f : nv;
            const float cv = cwv[n][0] * pv + cwv[n][1] * c4[j] + cwv[n][2] * nv;
            const float o = (EPI == EPI_FFN) ? siluf_(cv) * acc[m][n + 2][j] : acc[m][0][j] * cv;
            sO[(rb + j) * CW + colofs + n * 16] = f2bf(o);
          }
        }
        rb += 16;
        __syncthreads();
      }
      {
        constexpr int CH8 = CW / 8;
#pragma unroll
        for (int q = 0; q < (256 * CH8) / NTHR; ++q) {
          const int c = tid + NTHR * q, row = c / CH8, col8 = (c % CH8) * 8;
          const u16x8 v = *(const u16x8*)(sO + row * CW + col8);
          *(u16x8*)(g.C + (size_t)(row0 + row) * LDC + nt * CW + col8) = v;
        }
      }
      __syncthreads();
    }
  }
}

using f16x8 = __attribute__((ext_vector_type(8))) _Float16;
__device__ __forceinline__ void prep1_phase(const Params& p, int i, int nrows, const u16* __restrict__ P, h16* __restrict__ R,
                                            h16* __restrict__ Kk, h16* __restrict__ V, u16* __restrict__ L, u16* __restrict__ Dp) {
  const int TIDX = opaque_tid(); const int BIDX = opaque_bid();
  const int lane = TIDX & 63;
  const int gw = BIDX * NWV + (TIDX >> 6), nw = gridDim.x * NWV;
  const float* mu0 = p.ev_mu + (size_t)i * 2 * DPROJ;
  const float* mu1 = mu0 + DPROJ;
  float* KINV = (float*)(p.ws + B_KINV);
  float m0[3][8], m1[3][8], kkp[8], lm0[8], lm1[8];
#pragma unroll
  for (int q = 0; q < 3; ++q)
#pragma unroll
    for (int e = 0; e < 8; ++e) { int c = (lane + 64 * q) * 8 + e; m0[q][e] = mu0[c]; m1[q][e] = mu1[c]; }
#pragma unroll
  for (int e = 0; e < 8; ++e) kkp[e] = p.ev_k_k[i * 512 + lane * 8 + e];
  const int ll = lane < 36 ? lane : 35;
#pragma unroll
  for (int e = 0; e < 8; ++e) { lm0[e] = mu0[1536 + ll * 8 + e]; lm1[e] = mu1[1536 + ll * 8 + e]; }
  const int gi = lane >> 4, half = 1 << gi;
  const u16x8 zero8 = {0, 0, 0, 0, 0, 0, 0, 0};
  const int rpw = (nrows + nw - 1) / nw;
  const int r_begin = gw * rpw, r_end = min(r_begin + rpw, nrows);
  u16x8 cur[3], pv[3], nv[3], lc, lp, ln;
  float wsum[8];
#pragma unroll
  for (int e = 0; e < 8; ++e) wsum[e] = 0.f;
#pragma unroll 1
  for (int row = r_begin; row < r_end; ++row) {
    const bool lat = row < ML;
    const int t = lat ? (row & 4095) : ((row - ML) & 255);
    const int tl = lat ? 4095 : 255;
    const bool hp = t > 0, hn = t < tl;
    const u16* pc = P + (size_t)row * NEVP;
    const u16* pn = (row + 1 < MT) ? pc + NEVP : pc;
    if (row == r_begin) {
      const u16* pp = row > 0 ? pc - NEVP : pc;
#pragma unroll
      for (int q = 0; q < 3; ++q) { int c = (lane + 64 * q) * 8; cur[q] = *(const u16x8*)(pc + c); pv[q] = *(const u16x8*)(pp + c); }
      lc = *(const u16x8*)(pc + 1536 + ll * 8); lp = *(const u16x8*)(pp + 1536 + ll * 8);
    } else {
#pragma unroll
      for (int q = 0; q < 3; ++q) { pv[q] = cur[q]; cur[q] = nv[q]; }
      lp = lc; lc = ln;
    }
#pragma unroll
    for (int q = 0; q < 3; ++q) nv[q] = *(const u16x8*)(pn + (lane + 64 * q) * 8);
    ln = *(const u16x8*)(pn + 1536 + ll * 8);
    const int pos = lat ? (row & 63) : ((row - ML) & 255);
    const int Lr = lat ? 64 : 256;
    const u16* pool = pc + DPROJ + lane * 8;
    const u16x8 pcen = *(const u16x8*)(pool);
    if (row == r_begin || pos == 0) {
#pragma unroll
      for (int e = 0; e < 8; ++e) wsum[e] = 0.f;
#pragma unroll
      for (int dd = 0; dd < 16; ++dd) {
        const int d = dd - 8, jj = pos + d;
        const int jc = min(max(jj, 0), Lr - 1);
        const u16x8 w8 = *(const u16x8*)(pool + (ptrdiff_t)(jc - pos) * NEVP);
        const bool ok = d >= -half && d < half && jj >= 0 && jj < Lr;
        const float mk = ok ? 1.f : 0.f;
#pragma unroll
        for (int e = 0; e < 8; ++e) wsum[e] += mk * bf2f(w8[e]);
      }
    } else {
      const int ja = pos + half - 1, jr = pos - 1 - half;
      const int jac = min(ja, Lr - 1), jrc = max(jr, 0);
      const u16x8 wa = *(const u16x8*)(pool + (ptrdiff_t)(jac - pos) * NEVP);
      const u16x8 wr8 = *(const u16x8*)(pool + (ptrdiff_t)(jrc - pos) * NEVP);
      const float ma = (ja <= Lr - 1) ? 1.f : 0.f, mr = (jr >= 0) ? 1.f : 0.f;
#pragma unroll
      for (int e = 0; e < 8; ++e) wsum[e] += ma * bf2f(wa[e]) - mr * bf2f(wr8[e]);
    }
    float ssq = 0.f;
#pragma unroll
    for (int q = 0; q < 3; ++q) {
      f16x8 o;
#pragma unroll
      for (int e = 0; e < 8; ++e) {
        float c = bf2f(cur[q][e]);
        float a = hp ? bf2f(pv[q][e]) : 0.f;
        float n = hn ? bf2f(nv[q][e]) : 0.f;
        float sv = c + m0[q][e] * (a - c) + m1[q][e] * (n - c);
        o[e] = (h16)sv;
        if (q == 1) { float kr = sv * kkp[e]; ssq += kr * kr; }
      }
      h16* dst = q == 0 ? R : (q == 1 ? Kk : V);
      *(f16x8*)(dst + (size_t)row * 512 + lane * 8) = o;
    }
    ssq += __shfl_xor(ssq, 1);
    ssq += __shfl_xor(ssq, 2);
    ssq += __shfl_xor(ssq, 4);
    if ((lane & 7) == 0) KINV[(size_t)row * 8 + (lane >> 3)] = rsqrtf(fmaxf(ssq, 1e-24f));
    if (lane < 48) {
      u16x8 o = zero8;
      if (lane < 36) {
#pragma unroll
        for (int e = 0; e < 8; ++e) {
          float c = bf2f(lc[e]);
          float a = hp ? bf2f(lp[e]) : 0.f;
          float n = hn ? bf2f(ln[e]) : 0.f;
          float sv = c + lm0[e] * (a - c) + lm1[e] * (n - c);
          float ov = lane < 8 ? (1.f - 2.f * __builtin_amdgcn_rcpf(1.f + __expf(2.f * sv))) : (lane < 24 ? sv : sigmoidf_(sv));
          o[e] = f2bf(ov);
        }
      }
      *(u16x8*)(L + (size_t)row * LORA_K + lane * 8) = o;
    }
    {
      int lo = max(pos - half, 0), hi = min(pos + half, Lr);
      float inv = 1.f / (float)(hi - lo);
      u16x8 o;
#pragma unroll
      for (int e = 0; e < 8; ++e) o[e] = f2bf(wsum[e] * inv - bf2f(pcen[e]));
      *(u16x8*)(Dp + (size_t)row * 512 + lane * 8) = o;
    }
  }
}

__device__ __forceinline__ void scan_phase(const Params& p, int i, const h16* __restrict__ R, const h16* __restrict__ Kk,
                                           const h16* __restrict__ V, const h16* __restrict__ W0, const h16* __restrict__ W1,
                                           const h16* __restrict__ A0, const h16* __restrict__ A1, u16* __restrict__ Y0,
                                           u16* __restrict__ Y1, char* smem) {
  const int TIDX = opaque_tid(); const int BIDX = opaque_bid();
  const int tid = TIDX, wid = tid >> 6, lane = tid & 63;
  const int grp = lane >> 4, j16 = lane & 15;
  const float* KINV = (const float*)(p.ws + B_KINV);
  float* sOp = (float*)smem;
  const bool stager = tid >= 256;
  const int stid = tid & 255;
#pragma unroll 1
  for (int item = BIDX; item < 256; item += gridDim.x) {
    int half = item & 1, dir = (item >> 1) & 1, h = (item >> 2) & 7, b = item >> 5;
    const h16* Wd = dir ? W1 : W0;
    const h16* Ad = dir ? A1 : A0;
    u16* Yd = dir ? Y1 : Y0;
    int ss = stid >> 4, c4 = (stid & 15) * 4;
    float kkp[4], kap[4];
#pragma unroll
    for (int e = 0; e < 4; ++e) { kkp[e] = p.ev_k_k[i * 512 + h * 64 + c4 + e]; kap[e] = p.ev_k_a[i * 512 + h * 64 + c4 + e]; }
    const int rowA = half * 32 + (wid & 3) * 8 + grp * 2;
    f2 S0a = {0.f, 0.f}, S0b = {0.f, 0.f}, S1a = {0.f, 0.f}, S1b = {0.f, 0.f};

    auto tok_row = [&](int cidx, int s) -> int {
      if (cidx < 16) { int q = cidx * 16 + s; int tk = dir ? 255 - q : q; return ML + b * 256 + tk; }
      int q = (cidx - 16) * 16 + s; int tk = dir ? 4095 - q : q; return b * 4096 + tk;
    };
    h16x4 lr, lk, lv, lw, la; float linv;
    auto gload = [&](int cidx) {
      size_t o = (size_t)tok_row(cidx, ss) * 512 + h * 64 + c4;
      lr = *(const h16x4*)(R + o); lk = *(const h16x4*)(Kk + o); lv = *(const h16x4*)(V + o);
      lw = *(const h16x4*)(Wd + o); la = *(const h16x4*)(Ad + o);
      linv = KINV[(size_t)tok_row(cidx, ss) * 8 + h];
    };
    auto lstore = [&](int buf) {
      float* base = sOp + (size_t)buf * 16 * 6 * 64 + ss * 6 * 64 + c4;
      float4 kk4, w4, b4, kd4, r4, v4;
      float* kkf = (float*)&kk4; float* wf = (float*)&w4; float* bfp = (float*)&b4; float* kdf = (float*)&kd4;
      float* rf = (float*)&r4; float* vf = (float*)&v4;
#pragma unroll
      for (int e = 0; e < 4; ++e) {
        float k = (float)lk[e], a = (float)la[e];
        float kk = k * kkp[e] * linv;
        kkf[e] = kk;
        wf[e] = __expf((float)lw[e]);
        bfp[e] = kk * a;
        kdf[e] = k * (1.f + (a - 1.f) * kap[e]);
        rf[e] = (float)lr[e];
        vf[e] = (float)lv[e];
      }
      *(float4*)(base + 0 * 64) = kk4; *(float4*)(base + 1 * 64) = w4; *(float4*)(base + 2 * 64) = b4;
      *(float4*)(base + 3 * 64) = kd4; *(float4*)(base + 4 * 64) = r4; *(float4*)(base + 5 * 64) = v4;
    };
    __syncthreads();
    if (stager) { gload(0); lstore(0); }
    __syncthreads();
    constexpr int NCH = 16 + 256;
#pragma unroll 1
    for (int cidx = 0; cidx < NCH; ++cidx) {
      int buf = cidx & 1;
      if (stager) {
        if (cidx + 1 < NCH) { gload(cidx + 1); lstore(buf ^ 1); }
      } else {
        const float* cb = sOp + (size_t)buf * 16 * 6 * 64;
        float qa0[16], qa1[16];
        const float* lb = cb + j16 * 4;
        const float* vb = cb + 5 * 64 + rowA;
        float4 c_kk = *(const float4*)(lb + 0 * 64), c_w = *(const float4*)(lb + 1 * 64), c_b = *(const float4*)(lb + 2 * 64),
               c_kd = *(const float4*)(lb + 3 * 64), c_r = *(const float4*)(lb + 4 * 64);
        float2 c_v = *(const float2*)(vb);
#pragma unroll
        for (int s = 0; s < 16; ++s) {
          float4 n_kk, n_w, n_b, n_kd, n_r; float2 n_v;
          if (s < 15) {
            const float* nb = lb + (s + 1) * 6 * 64;
            n_kk = *(const float4*)(nb + 0 * 64); n_w = *(const float4*)(nb + 1 * 64); n_b = *(const float4*)(nb + 2 * 64);
            n_kd = *(const float4*)(nb + 3 * 64); n_r = *(const float4*)(nb + 4 * 64);
            n_v = *(const float2*)(vb + (s + 1) * 6 * 64);
          }
          const f2 kka = {c_kk.x, c_kk.y}, kkb = {c_kk.z, c_kk.w}, wa = {c_w.x, c_w.y}, wb = {c_w.z, c_w.w};
          const f2 ba = {c_b.x, c_b.y}, bb = {c_b.z, c_b.w}, kda = {c_kd.x, c_kd.y}, kdb = {c_kd.z, c_kd.w};
          const f2 ra = {c_r.x, c_r.y}, rb = {c_r.z, c_r.w};
          f2 t0 = __builtin_elementwise_fma(S0b, kkb, S0a * kka);
          f2 t1 = __builtin_elementwise_fma(S1b, kkb, S1a * kka);
          float sa0 = t0.x + t0.y, sa1 = t1.x + t1.y;
          const f2 v0 = {c_v.x, c_v.x}, v1 = {c_v.y, c_v.y};
          f2 u0a = v0 * kda, u0b = v0 * kdb, u1a = v1 * kda, u1b = v1 * kdb;
          sa0 = row16_sum(sa0);
          sa1 = row16_sum(sa1);
          const f2 ns0 = {-sa0, -sa0}, ns1 = {-sa1, -sa1};
          u0a = __builtin_elementwise_fma(ns0, ba, u0a); u0b = __builtin_elementwise_fma(ns0, bb, u0b);
          u1a = __builtin_elementwise_fma(ns1, ba, u1a); u1b = __builtin_elementwise_fma(ns1, bb, u1b);
          S0a = __builtin_elementwise_fma(S0a, wa, u0a); S0b = __builtin_elementwise_fma(S0b, wb, u0b);
          S1a = __builtin_elementwise_fma(S1a, wa, u1a); S1b = __builtin_elementwise_fma(S1b, wb, u1b);
          f2 q0 = __builtin_elementwise_fma(S0b, rb, S0a * ra);
          f2 q1 = __builtin_elementwise_fma(S1b, rb, S1a * ra);
          qa0[s] = q0.x + q0.y; qa1[s] = q1.x + q1.y;
          if (s < 15) { c_kk = n_kk; c_w = n_w; c_b = n_b; c_kd = n_kd; c_r = n_r; c_v = n_v; }
        }
        const float yk0 = row16_transpose_sum(qa0, j16), yk1 = row16_transpose_sum(qa1, j16);
        size_t o = (size_t)tok_row(cidx, j16) * 512 + h * 64 + rowA;
        unsigned pk = (unsigned)f2bf(yk0) | ((unsigned)f2bf(yk1) << 16);
        *(unsigned*)(Yd + o) = pk;
      }
      __syncthreads();
    }
  }
}

__device__ __forceinline__ float grp8_sum(float x) {
  x += __shfl_xor(x, 1);
  x += __shfl_xor(x, 2);
  x += __shfl_xor(x, 4);
  return x;
}
__device__ __forceinline__ void merge_phase(const Params& p, int i, int nrows, const h16* __restrict__ R, const h16* __restrict__ Kk,
                                            const h16* __restrict__ V, const h16* __restrict__ A0, const h16* __restrict__ A1,
                                            const h16* __restrict__ Gt, const u16* __restrict__ Y0, const u16* __restrict__ Y1,
                                            u16* __restrict__ YC  ) {
  const int TIDX = opaque_tid(); const int BIDX = opaque_bid();
  const int lane = TIDX & 63;
  const int gw = BIDX * NWV + (TIDX >> 6), nw = gridDim.x * NWV;
  float gnw[8], gnb[8], ka[8], rk[8];
#pragma unroll
  for (int e = 0; e < 8; ++e) {
    int c = i * 512 + lane * 8 + e;
    gnw[e] = p.ev_gn_w[c]; gnb[e] = p.ev_gn_b[c]; ka[e] = p.ev_k_a[c]; rk[e] = p.ev_r_k[c];
  }
#pragma unroll 1
  for (int row = gw; row < nrows; row += nw) {
    size_t o = (size_t)row * 512 + lane * 8;
    u16x8 y0 = *(const u16x8*)(Y0 + o), y1 = *(const u16x8*)(Y1 + o);
    f16x8 k8 = *(const f16x8*)(Kk + o), a08 = *(const f16x8*)(A0 + o), a18 = *(const f16x8*)(A1 + o);
    f16x8 r8 = *(const f16x8*)(R + o), v8 = *(const f16x8*)(V + o), g8 = *(const f16x8*)(Gt + o);
    float y[8], s = 0.f, cf = 0.f;
#pragma unroll
    for (int e = 0; e < 8; ++e) {
      y[e] = bf2f(y0[e]) + bf2f(y1[e]);
      s += y[e];
      float kd = (float)k8[e] * (2.f + ((float)a08[e] + (float)a18[e] - 2.f) * ka[e]);
      cf += (float)r8[e] * rk[e] * kd;
    }
    float mean = grp8_sum(s) * (1.f / 64.f);
    cf = grp8_sum(cf);
    float vs = 0.f;
#pragma unroll
    for (int e = 0; e < 8; ++e) { y[e] -= mean; vs += y[e] * y[e]; }
    float rs = rsqrtf(grp8_sum(vs) * (1.f / 64.f) + GN_EPS);
    u16x8 ov;
#pragma unroll
    for (int e = 0; e < 8; ++e) ov[e] = f2bf((y[e] * rs * gnw[e] + gnb[e] + cf * (float)v8[e]) * (float)g8[e]);
    *(u16x8*)(YC + (size_t)row * 1024 + lane * 8) = ov;
  }
}

__device__ __forceinline__ void gemm8_bf16(const GemmP& g, char* smem) {
  const int BIDX = opaque_bid();
  pg8::Gemm gg{g.A1, g.Bt, g.mtiles * 256, g.ntn * 256, g.K};
  pg8::TileOrder S{g.ntn, g.mtiles * g.ntn, (int)gridDim.x, vblock(BIDX)};
  pg8::EpiStoreBf16 E{g.C, g.ldc};
  pg8::gemm_phase<pg8::EpiStoreBf16, pg8::TileOrder, false>((PG8_LAS unsigned char*)smem, gg, S, E, nullptr);
}

__device__ __forceinline__ void gemm8_ffn(const GemmP& g, char* smem) {
  const int BIDX = opaque_bid();
  pg8::Gemm gg{g.A1, g.Bt, g.mtiles * 256, g.ntn * 256, g.K};
  pg8::TileOrder S{g.ntn, g.mtiles * g.ntn, (int)gridDim.x, vblock(BIDX)};
  pg8::EpiFfnConv E{g.C, g.cw, (PG8_LAS float*)(smem + SMEM_BYTES)};
  pg8::gemm_phase<pg8::EpiFfnConv, pg8::TileOrder, false>((PG8_LAS unsigned char*)smem, gg, S, E, nullptr);
}

constexpr int NPHASES = 34;
enum { T_PRE = 0, T_ROW, T_GEMM_BF16, T_PREP1, T_LORA, T_SCAN, T_MERGE, T_FFN, T_ODD };

__global__ void __launch_bounds__(NTHR, 1) mega(Params p, int ph_lo, int ph_hi, int coop) {
  __shared__ __attribute__((aligned(16))) char smem[SMEM_BYTES + 8192];
  cg::grid_group grid = cg::this_grid();
  volatile LAS unsigned* xst = (volatile LAS unsigned*)(smem + SMEM_BYTES + 8176);
  if (threadIdx.x == 0) { xst[0] = 0u; xst[1] = 0u; }
  __syncthreads();
  XcdBarrier xb{};
  if (coop && blockIdx.x == 0) for (int e = threadIdx.x; e < 4096; e += NTHR) ((unsigned*)(p.ws + B_BAR))[e] = 0u;
  bool first_sync = true;
  const u16* W = (const u16*)p.ws;
  const float* MOD = (const float*)(p.ws + B_MOD);
  u16* H = (u16*)ACT(p, 0);
  u16* Y = (u16*)ACT(p, 2);
  u16* G = (u16*)ACT(p, 4);
  u16* P = (u16*)ACT(p, 6);
  h16* Rr = (h16*)ACT(p, 2);
  h16* Kk = (h16*)ACT(p, 3);
  h16* Vv = (h16*)ACT(p, 4);
  u16* Dp = (u16*)ACT(p, 5);
  u16* L = (u16*)ACT(p, 0);
  h16* LO = (h16*)ACT(p, 6);
  u16* Y0 = (u16*)ACT(p, 0);
  u16* Y1 = (u16*)ACT(p, 1);
  u16* YC = (u16*)ACT(p, 6);
  u16* G1 = (u16*)ACT(p, 4);

#pragma unroll 1
  for (int ph = ph_lo; ph < ph_hi; ++ph) {
    int type, l = 0, pos = 0;
    if (ph == 0) type = T_PRE;
    else if (ph == 1) { type = T_ROW; pos = -1; }
    else {
      if (ph < 12) { l = 0; pos = ph - 2; }
      else if (ph < 18) { l = 1; pos = ph - 12; }
      else if (ph < 28) { l = 2; pos = ph - 18; }
      else { l = 3; pos = ph - 28; }
      if (l & 1) pos = pos == 0 ? 10 : (pos == 1 ? 5 : pos + 4);
      type = pos == 0 ? T_GEMM_BF16 : pos == 1 ? T_PREP1 : pos == 2 ? T_LORA : pos == 3 ? T_SCAN : pos == 4 ? T_MERGE
           : pos == 5 ? T_GEMM_BF16 : pos == 6 ? T_ROW : pos == 7 ? T_FFN : pos == 8 ? T_GEMM_BF16 : pos == 9 ? T_ROW : T_ODD;
    }
    const int reps = 1 + ((REP_MASK >> type) & 1);
#pragma unroll 1
    for (int rep = 0; rep < reps; ++rep) {
    const int i = l >> 1;
    const bool even = (l & 1) == 0;
    const bool ctx_later = l < 2;
    const bool ctx_in = l <= 2;
    const float* MODL = MOD + (size_t)l * 9 * 6144;
    const float* gn = p.norm_g + (size_t)l * 4 * D;
    GemmP g{};
    g.conv = 0;
    if (pos == 0) {
      g.A1 = H; g.A2 = H; g.lda1 = D; g.lda2 = D; g.ksplit = D; g.Bt = W + OFF_EVIN + i * SZ_EVIN; g.K = D;
      g.ntn = NEVP / 256; g.mtiles = ctx_in ? 136 : 128; g.C = P; g.ldc = NEVP;
    } else if (pos == 2) {
      g.A1 = L; g.A2 = L; g.lda1 = LORA_K; g.lda2 = LORA_K; g.ksplit = LORA_K; g.Bt = W + OFF_LORA + i * SZ_LORA; g.K = LORA_K;
      g.ntn = LORA_N / 256; g.mtiles = ctx_in ? 136 : 128;
      g.w0 = p.ev_w0 + i * 1024; g.a0 = p.ev_a0 + i * 1024; g.lout = LO;
    } else if (pos == 5) {
      if (even) { g.A1 = YC; g.A2 = YC; g.lda1 = D; g.lda2 = D; g.ksplit = D; g.Bt = W + OFF_EVOUT + i * SZ_SQ; }
      else { g.A1 = G1; g.A2 = G1; g.lda1 = D; g.lda2 = D; g.ksplit = D; g.Bt = W + OFF_ODOUT + i * SZ_SQ; }
      g.K = D; g.ntn = 4; g.mtiles = ctx_later ? 136 : 128; g.C = Y; g.ldc = D;
    } else if (pos == 7) {
      g.A1 = H; g.A2 = H; g.lda1 = D; g.lda2 = D; g.ksplit = D; g.Bt = W + OFF_FFNUP + l * SZ_FFNUP; g.K = D;
      g.ntn = 22; g.mtiles = ctx_later ? 136 : 128; g.conv = 1; g.C = G; g.ldc = DFF;
      g.cw = p.ffn_conv + (size_t)l * 3 * DFF; g.cwC = DFF;
    } else if (pos == 8) {
      g.A1 = G; g.A2 = G; g.lda1 = DFF; g.lda2 = DFF; g.ksplit = DFF; g.Bt = W + OFF_FFNDN + l * SZ_FFNDN; g.K = DFF;
      g.ntn = 4; g.mtiles = ctx_later ? 136 : 128; g.C = Y; g.ldc = D;
    } else if (pos == 10) {
      g.A1 = H; g.A2 = H; g.lda1 = D; g.lda2 = D; g.ksplit = D; g.Bt = W + OFF_ODIN + i * SZ_ODIN; g.K = D;
      g.ntn = 16; g.mtiles = ctx_later ? 136 : 128; g.conv = 1; g.C = G1; g.ldc = D;
      g.cw = p.od_conv + (size_t)i * 3 * D; g.cwC = D;
    }
    switch (type) {
      case T_PRE: pre_phase(p, smem); break;
      case T_ROW:
        if (pos == -1) row_phase(p, false, true, MT, nullptr, MOD, 0, p.norm_g, p.norm_g, MOD, 0, H, true);
        else if (pos == 6) row_phase(p, true, true, ctx_later ? MT : ML, Y, MODL, 2, gn + D, gn + 2 * D, MODL, 3, H, l == 0);
        else row_phase(p, true, l < DEPTH - 1, ctx_later ? MT : ML, Y, MODL, 5, gn + 3 * D, gn + (l < DEPTH - 1 ? 4 * D : 0),
                       MODL + (l < DEPTH - 1 ? 9 * 6144 : 0), 0, H, false);
        break;
      case T_PREP1: prep1_phase(p, i, ctx_in ? MT : ML, P, Rr, Kk, Vv, L, Dp); break;
      case T_LORA: gemm_phase<4, EPI_LORA>(g, smem); break;
      case T_GEMM_BF16: gemm8_bf16(g, smem); break;
      case T_SCAN:
        scan_phase(p, i, Rr, Kk, Vv, LO, LO + (size_t)MT * 512, LO + (size_t)2 * MT * 512, LO + (size_t)3 * MT * 512, Y0, Y1, smem);
        break;
      case T_MERGE:
        merge_phase(p, i, ctx_later ? MT : ML, Rr, Kk, Vv, LO + (size_t)2 * MT * 512, LO + (size_t)3 * MT * 512,
                    LO + (size_t)4 * MT * 512, Y0, Y1, YC);
        g.A1 = Dp; g.A2 = Dp; g.lda1 = 512; g.lda2 = 512; g.ksplit = 512; g.Bt = W + OFF_POOL + i * SZ_POOL; g.K = 512;
        g.ntn = 2; g.mtiles = ctx_later ? 136 : 128; g.C = YC + 512; g.ldc = 1024;
        gemm8_bf16(g, smem);
        break;
      case T_FFN: gemm8_ffn(g, smem); break;
      case T_ODD: gemm_phase<3, EPI_ODD>(g, smem); break;
    }
    if (coop && (ph + 1 < ph_hi || rep + 1 < reps)) {
      if (first_sync) { grid.sync(); first_sync = false; xb = xcd_barrier_post((unsigned*)(p.ws + B_BAR), xst); }
      else xcd_barrier(xb);
    }
    }
  }
}

extern "C" void kernel_launch(void* const* d_in, const int* in_sizes, int n_in, void* d_out, int out_size, void* d_ws,
                              size_t ws_size, hipStream_t stream) {
  Params p{};
  const float** pp = (const float**)&p;
  for (int k = 0; k < 28; ++k) pp[k] = (const float*)d_in[k];
  p.out = (float*)d_out;
  p.ws = (char*)d_ws;
  static int grid_blocks = 0;
  if (!grid_blocks) {
    int dev = 0, cus = 0, per_cu = 0;
    (void)hipGetDevice(&dev);
    (void)hipDeviceGetAttribute(&cus, hipDeviceAttributeMultiprocessorCount, dev);
    (void)hipOccupancyMaxActiveBlocksPerMultiprocessor(&per_cu, mega, NTHR, 0);
    if (per_cu > 1) per_cu = 1;
    if (per_cu < 1) per_cu = 1;
    grid_blocks = cus * per_cu;
    grid_blocks -= grid_blocks % 8;
  }
#if COOP
  int lo = 0, hi = NPHASES, coop = 1;
  void* args[] = {&p, &lo, &hi, &coop};
  hipError_t e = hipLaunchCooperativeKernel((void*)mega, dim3(grid_blocks), dim3(NTHR), args, 0, stream);
  if (e != hipSuccess) fprintf(stderr, "cooperative launch failed: %s (grid %d)\n", hipGetErrorString(e), grid_blocks);
#else
  for (int ph = 0; ph < NPHASES; ++ph) hipLaunchKernelGGL(mega, dim3(grid_blocks), dim3(NTHR), 0, stream, p, ph, ph + 1, 0);
#endif
}
```

```cpp
#include <hip/hip_runtime.h>
#include <hip/hip_bf16.h>
#include <hip/hip_cooperative_groups.h>
#include <cstdio>
namespace cg = cooperative_groups;

typedef unsigned short u16;
typedef _Float16 h16;
using bf16x8 = __attribute__((ext_vector_type(8))) short;
using f32x4 = __attribute__((ext_vector_type(4))) float;
typedef float f2 __attribute__((ext_vector_type(2)));
using h16x4 = __attribute__((ext_vector_type(4))) _Float16;
using u16x4 = __attribute__((ext_vector_type(4))) unsigned short;
using u16x8 = __attribute__((ext_vector_type(8))) unsigned short;

#ifndef REP_MASK
#define REP_MASK 0
#endif
#ifndef COOP
#define COOP 1
#endif

constexpr int D = 1024, NB = 8, SEQ = 4096, CTX = 256, DEPTH = 4;
constexpr int ML = NB * SEQ;
constexpr int MC = NB * CTX;
constexpr int MT = ML + MC;
constexpr int DFF = 2816;
constexpr int NEV = 2336, NEVP = 2560, DPROJ = 1824;
constexpr int NTHR = 512, NWV = 8;
constexpr int LORA_K = 384, LORA_N = 2560;
constexpr float RMS_EPS = 1e-6f, GN_EPS = 64e-5f;

constexpr size_t SZ_FFNUP = 5632ull * 1024, SZ_FFNDN = 1024ull * 2816, SZ_EVIN = 2560ull * 1024, SZ_SQ = 1024ull * 1024,
                 SZ_LORA = 2560ull * 384, SZ_POOL = 512ull * 512, SZ_ODIN = 3072ull * 1024;
constexpr size_t OFF_FFNUP = 0;
constexpr size_t OFF_FFNDN = OFF_FFNUP + 4 * SZ_FFNUP;
constexpr size_t OFF_EVIN = OFF_FFNDN + 4 * SZ_FFNDN;
constexpr size_t OFF_EVOUT = OFF_EVIN + 2 * SZ_EVIN;
constexpr size_t OFF_LORA = OFF_EVOUT + 2 * SZ_SQ;
constexpr size_t OFF_POOL = OFF_LORA + 2 * SZ_LORA;
constexpr size_t OFF_ODIN = OFF_POOL + 2 * SZ_POOL;
constexpr size_t OFF_ODOUT = OFF_ODIN + 2 * SZ_ODIN;
constexpr size_t W_ELEMS = OFF_ODOUT + 2 * SZ_SQ;
constexpr size_t B_MOD = W_ELEMS * 2;
constexpr size_t B_XC = B_MOD + 4ull * 9 * 6144 * 4;
constexpr size_t B_KINV = B_XC + (size_t)MC * D * 4;
constexpr size_t B_BAR = B_KINV + (size_t)MT * 8 * 4;
constexpr size_t B_ACT = B_BAR + 16384;
constexpr size_t UU = (size_t)MT * 512 * 2;
#define ACT(p, u) ((p).ws + B_ACT + (size_t)(u) * UU)

struct Params {
  const float *x, *c, *ctx, *c_ctx, *w_mod, *b_mod, *norm_g, *ffn_w_up, *ffn_conv, *ffn_w_down,
      *ev_w_in, *ev_w_out, *ev_mu, *ev_w0, *ev_w_up, *ev_a0, *ev_a_up, *ev_g_up, *ev_k_k, *ev_k_a, *ev_r_k,
      *ev_gn_w, *ev_gn_b, *ev_pool_w, *ev_pool_scale, *od_w_in, *od_conv, *od_w_out;
  float* out;
  char* ws;
};

__device__ __forceinline__ u16 f2bf(float f) {
  unsigned u = __float_as_uint(f);
  u += 0x7fffu + ((u >> 16) & 1u);
  return (u16)(u >> 16);
}
__device__ __forceinline__ float bf2f(u16 h) { return __uint_as_float(((unsigned)h) << 16); }
__device__ __forceinline__ float sigmoidf_(float x) { return __builtin_amdgcn_rcpf(1.f + __expf(-x)); }
__device__ __forceinline__ float siluf_(float x) { return x * __builtin_amdgcn_rcpf(1.f + __expf(-x)); }

template <int CTRL>
__device__ __forceinline__ float dppf(float x) {
  return __builtin_bit_cast(float, __builtin_amdgcn_update_dpp(0, __builtin_bit_cast(int, x), CTRL, 0xf, 0xf, true));
}
__device__ __forceinline__ float row16_sum(float x) {
  x += dppf<0x128>(x);
  x += dppf<0x124>(x);
  x += dppf<0x122>(x);
  x += dppf<0x121>(x);
  return x;
}
__device__ __forceinline__ float row16_transpose_sum(const float (&q)[16], int j16) {
  const bool b3 = (j16 & 8) != 0, b2 = (j16 & 4) != 0, b1 = (j16 & 2) != 0, b0 = (j16 & 1) != 0;
  float r1[8], r2[4], r3[2];
#pragma unroll
  for (int i = 0; i < 8; ++i) { float keep = b3 ? q[i + 8] : q[i], send = b3 ? q[i] : q[i + 8]; r1[i] = keep + dppf<0x140>(send); }
#pragma unroll
  for (int i = 0; i < 4; ++i) { float keep = b2 ? r1[i + 4] : r1[i], send = b2 ? r1[i] : r1[i + 4]; r2[i] = keep + dppf<0x141>(send); }
#pragma unroll
  for (int i = 0; i < 2; ++i) { float keep = b1 ? r2[i + 2] : r2[i], send = b1 ? r2[i] : r2[i + 2]; r3[i] = keep + dppf<0x1B>(send); }
  float keep = b0 ? r3[1] : r3[0], send = b0 ? r3[0] : r3[1];
  return keep + dppf<0xB1>(send);
}
__device__ __forceinline__ float wave_sum(float x) {
  x = row16_sum(x);
  x += __shfl_xor(x, 16);
  x += __shfl_xor(x, 32);
  return x;
}

__device__ __forceinline__ int opaque_tid() { int t = threadIdx.x; asm volatile("" : "+v"(t)); return t; }
__device__ __forceinline__ int opaque_bid() { int t = blockIdx.x; asm volatile("" : "+s"(t)); return t; }
__device__ __forceinline__ int vblock(int bid) { return (bid & 7) * (gridDim.x >> 3) + (bid >> 3); }

#define XB_TMO      128
#define XB_XCNT(j)  (256  + 64 * (j))
#define XB_XSUB(j)  (1280 + 64 * (j))
#define XB_XGEN(j)  (2304 + 64 * (j))
#define XB_TOP      3328
#define XB_TOPGEN   3392
#define XCD_BAR_WORDS 3456
#define XB_SPIN_CAP (1u << 18)
#define LAS __attribute__((address_space(3)))

__device__ __forceinline__ unsigned xb_ld(unsigned* p)              { return __hip_atomic_load(p, __ATOMIC_RELAXED, __HIP_MEMORY_SCOPE_AGENT); }
__device__ __forceinline__ unsigned xb_add(unsigned* p, unsigned v) { return __hip_atomic_fetch_add(p, v, __ATOMIC_RELAXED, __HIP_MEMORY_SCOPE_AGENT); }
__device__ __forceinline__ unsigned xb_xcc_id() { return (unsigned)__builtin_amdgcn_s_getreg((3 << 11) | 20) & 0xFu; }
#define XB_SPIN(cond, bar) do { unsigned _sp = 0; while (cond) { __builtin_amdgcn_s_sleep(1); \
    if ((++_sp & 255u) == 0u) { if (xb_ld(&(bar)[XB_TMO])) break; if (_sp > XB_SPIN_CAP) { atomicAdd(&(bar)[XB_TMO], 1u); break; } } } } while (0)

struct XcdBarrier {
    unsigned* bar; unsigned x;
    volatile LAS unsigned* st;
};

__device__ __forceinline__ XcdBarrier xcd_barrier_post(unsigned* bar, volatile LAS unsigned* st) {
    XcdBarrier b; b.bar = bar; b.x = xb_xcc_id(); b.st = st;
    if (threadIdx.x == 0) (void)xb_add(&bar[XB_XCNT(b.x)], 1u);
    return b;
}
__device__ __forceinline__ void xcd_barrier_complete(unsigned* bar, unsigned x, unsigned& nloc, unsigned& nx) {
    const unsigned G = gridDim.x * gridDim.y * gridDim.z;
    unsigned sum, cnt, mine, sp = 0u;
    for (;;) {
        sum = 0u; cnt = 0u; mine = 0u;
#pragma unroll
        for (unsigned j = 0; j < 16; ++j) { const unsigned c = xb_ld(&bar[XB_XCNT(j)]); sum += c; cnt += (c > 0u) ? 1u : 0u; mine = (j == x) ? c : mine; }
        if (sum == G) break;
        __builtin_amdgcn_s_sleep(1);
        if ((++sp & 255u) == 0u) { if (xb_ld(&bar[XB_TMO])) break; if (sp > XB_SPIN_CAP) { atomicAdd(&bar[XB_TMO], 1u); break; } }
    }
    nloc = mine > 0u ? mine : 1u; nx = cnt > 0u ? cnt : 1u;
}

__device__ __forceinline__ void xcd_barrier(const XcdBarrier& b) {
    asm volatile("s_waitcnt vmcnt(0)" ::: "memory");
    __syncthreads();
    if (threadIdx.x == 0) {
        unsigned* bar = b.bar;
        __builtin_amdgcn_s_waitcnt(0);
        unsigned nloc = b.st[0], nx = b.st[1];
        if (nloc == 0u) { xcd_barrier_complete(bar, b.x, nloc, nx); b.st[0] = nloc; b.st[1] = nx; }
        const unsigned old = xb_add(&bar[XB_XSUB(b.x)], 1u);
        const unsigned gen = old / nloc;
        if (old + 1u == (gen + 1u) * nloc) {
            __builtin_amdgcn_fence(__ATOMIC_RELEASE, "agent");
            asm volatile("s_waitcnt vmcnt(0)" ::: "memory");
            const unsigned og = xb_add(&bar[XB_TOP], 1u);
            const unsigned tg = og / nx;
            if (og + 1u == (tg + 1u) * nx) xb_add(&bar[XB_TOPGEN], 1u);
            else XB_SPIN(xb_ld(&bar[XB_TOPGEN]) == tg, bar);
            __builtin_amdgcn_fence(__ATOMIC_ACQUIRE, "agent");
            xb_add(&bar[XB_XGEN(b.x)], 1u);
            asm volatile("s_waitcnt vmcnt(0)" ::: "memory");
        } else {
            XB_SPIN(xb_ld(&bar[XB_XGEN(b.x)]) == gen, bar);
            __builtin_amdgcn_fence(__ATOMIC_ACQUIRE, "agent");
            asm volatile("s_waitcnt vmcnt(0)" ::: "memory");
        }
    }
    __syncthreads();
}

__device__ __forceinline__ int map_col(int kind, int nd, int srcN) {
  if (kind == 0) return nd < srcN ? nd : -1;
  if (kind == 3) {
    int t = nd >> 8, half = (nd >> 7) & 1, j = nd & 127;
    return half * DFF + t * 128 + j;
  }
  if (kind == 1) {
    int t = nd >> 7, r = nd & 127, wc = r >> 6, half = (r >> 5) & 1, j = r & 31;
    return half * DFF + t * 64 + wc * 32 + j;
  }
  int t = nd / 96, r = nd % 96, wc = r / 48, part = (r % 48) >> 4, j = r & 15;
  return part * 1024 + t * 32 + wc * 16 + j;
}

__device__ __forceinline__ size_t wt_off(int n, int k, int K, int BN) {
  int nb = n / BN, nr = n - nb * BN;
  int pos = ((k >> 3) & 7) ^ ((nr >> 1) & 7);
  return ((size_t)nb * (K >> 6) + (k >> 6)) * (size_t)(BN * 64) + nr * 64 + pos * 8 + (k & 7);
}

__device__ void conv_tile(const float* __restrict__ src, int srcN, int K, u16* __restrict__ dst, int kind, int tile,
                          int ntn64, float* sT, int tiledBN) {
  const int TIDX = opaque_tid(); const int BIDX = opaque_bid(); (void)TIDX; (void)BIDX;
  int tn = tile % ntn64, tk = tile / ntn64;
  int n0 = tn * 64, k0 = tk * 256;
  int tx = TIDX & 63, ty = TIDX >> 6;
  int sc = map_col(kind, n0 + tx, srcN);
  float vals[32];
#pragma unroll
  for (int q = 0; q < 32; ++q) vals[q] = sc >= 0 ? src[(size_t)(k0 + ty + 8 * q) * srcN + sc] : 0.f;
#pragma unroll
  for (int q = 0; q < 32; ++q) sT[(ty + 8 * q) * 65 + tx] = vals[q];
  __syncthreads();
  int n = TIDX >> 3;
#pragma unroll
  for (int jq = 0; jq < 4; ++jq) {
    int kq = (TIDX & 7) * 8 + 64 * jq;
    u16x8 o0;
#pragma unroll
    for (int e = 0; e < 8; ++e) o0[e] = f2bf(sT[(kq + e) * 65 + n]);
    u16* d = dst + (tiledBN ? wt_off(n0 + n, k0 + kq, K, tiledBN) : (size_t)(n0 + n) * K + k0 + kq);
    *(u16x8*)d = o0;
  }
  __syncthreads();
}

__device__ __forceinline__ void pre_phase(const Params& p, char* smem) {
  const int TIDX = opaque_tid(); const int BIDX = opaque_bid(); (void)TIDX; (void)BIDX;
  u16* W = (u16*)p.ws;
  float* sT = (float*)smem;
  constexpr int T_UP = 88 * 4, T_DN = 16 * 11, T_EVIN = 40 * 4, T_SQ = 64, T_ODIN = 48 * 4;
  constexpr int N_BIG = 4 * T_UP + 4 * T_DN + 2 * (T_EVIN + T_SQ + T_ODIN + T_SQ);
  constexpr int N_LORA = 240, N_POOL = 64;
  constexpr int N_SMALL = 2 * (N_LORA + N_POOL);
  constexpr int N_MOD = 4 * 96;
  constexpr int N_ALL = N_BIG + N_SMALL + N_MOD;
  for (int it = BIDX; it < N_ALL; it += gridDim.x) {
    if (it < N_MOD) {
      int l = it / 96, c0 = (it % 96) * 64;
      float* sS = (float*)smem;
      float* sR = sS + 9 * 1024;
      for (int e = TIDX; e < 9 * 1024; e += NTHR) {
        int j = e >> 10, k = e & 1023;
        float cv = j < 8 ? p.c[j * 1024 + k] : p.c_ctx[k];
        sS[e] = siluf_(cv);
      }
      __syncthreads();
      int w = TIDX >> 6, lane = TIDX & 63;
      float acc[9];
#pragma unroll
      for (int j = 0; j < 9; ++j) acc[j] = 0.f;
      const float* wm = p.w_mod + (size_t)l * 1024 * 6144 + c0 + lane;
#pragma unroll 8
      for (int k = w * 128; k < w * 128 + 128; ++k) {
        float wv = wm[(size_t)k * 6144];
#pragma unroll
        for (int j = 0; j < 9; ++j) acc[j] += sS[j * 1024 + k] * wv;
      }
#pragma unroll
      for (int j = 0; j < 9; ++j) sR[(w * 9 + j) * 64 + lane] = acc[j];
      __syncthreads();
      for (int e = TIDX; e < 9 * 64; e += NTHR) {
        int j = e >> 6, cc = e & 63;
        float s = 0.f;
#pragma unroll
        for (int ww = 0; ww < 8; ++ww) s += sR[(ww * 9 + j) * 64 + cc];
        s += p.b_mod[l * 6144 + c0 + cc];
        ((float*)(p.ws + B_MOD))[(size_t)(l * 9 + j) * 6144 + c0 + cc] = s;
      }
      __syncthreads();
      continue;
    }
    int t = it - N_MOD;
    if (t < N_BIG) {
      if (t < 4 * T_UP) {
        int l = t / T_UP;
        conv_tile(p.ffn_w_up + (size_t)l * 1024 * 5632, 5632, 1024, W + OFF_FFNUP + l * SZ_FFNUP, 3, t % T_UP, 88, sT, 0);
        continue;
      }
      t -= 4 * T_UP;
      if (t < 4 * T_DN) {
        int l = t / T_DN;
        conv_tile(p.ffn_w_down + (size_t)l * 2816 * 1024, 1024, 2816, W + OFF_FFNDN + l * SZ_FFNDN, 0, t % T_DN, 16, sT, 0);
        continue;
      }
      t -= 4 * T_DN;
      if (t < 2 * T_EVIN) {
        int i = t / T_EVIN;
        conv_tile(p.ev_w_in + (size_t)i * 1024 * NEV, NEV, 1024, W + OFF_EVIN + i * SZ_EVIN, 0, t % T_EVIN, 40, sT, 0);
        continue;
      }
      t -= 2 * T_EVIN;
      if (t < 2 * T_SQ) {
        int i = t / T_SQ;
        conv_tile(p.ev_w_out + (size_t)i * SZ_SQ, 1024, 1024, W + OFF_EVOUT + i * SZ_SQ, 0, t % T_SQ, 16, sT, 0);
        continue;
      }
      t -= 2 * T_SQ;
      if (t < 2 * T_ODIN) {
        int i = t / T_ODIN;
        conv_tile(p.od_w_in + (size_t)i * 1024 * 3072, 3072, 1024, W + OFF_ODIN + i * SZ_ODIN, 2, t % T_ODIN, 48, sT, 192);
        continue;
      }
      t -= 2 * T_ODIN;
      {
        int i = t / T_SQ;
        conv_tile(p.od_w_out + (size_t)i * SZ_SQ, 1024, 1024, W + OFF_ODOUT + i * SZ_SQ, 0, t % T_SQ, 16, sT, 0);
        continue;
      }
    }
    t -= N_BIG;
    {
      int i = t / (N_LORA + N_POOL);
      int r = t % (N_LORA + N_POOL);
      if (r < N_LORA) {
        u16* dst = W + OFF_LORA + i * SZ_LORA;
        for (int e = r * 4096 + TIDX; e < r * 4096 + 4096; e += NTHR) {
          const int e_K = LORA_K;
          int n = e / LORA_K, k = e % LORA_K;
          int seg = n >> 9, cc = n & 511;
          float v = 0.f;
          if (seg == 0) { if (k < 32) v = p.ev_w_up[((size_t)(i * 2 + 0) * 32 + k) * 512 + cc]; }
          else if (seg == 1) { if (k >= 32 && k < 64) v = p.ev_w_up[((size_t)(i * 2 + 1) * 32 + (k - 32)) * 512 + cc]; }
          else if (seg == 2) { if (k >= 64 && k < 128) v = p.ev_a_up[((size_t)(i * 2 + 0) * 64 + (k - 64)) * 512 + cc]; }
          else if (seg == 3) { if (k >= 128 && k < 192) v = p.ev_a_up[((size_t)(i * 2 + 1) * 64 + (k - 128)) * 512 + cc]; }
          else { if (k >= 192 && k < 288) v = p.ev_g_up[((size_t)i * 96 + (k - 192)) * 512 + cc]; }
          dst[wt_off(n, k, e_K, 256)] = f2bf(v);
        }
      } else {
        r -= N_LORA;
        u16* dst = W + OFF_POOL + i * SZ_POOL;
        for (int e = r * 4096 + TIDX; e < r * 4096 + 4096; e += NTHR) {
          int n = e >> 9, k = e & 511;
          float v = 0.f;
          int g = n >> 7;
          if ((k >> 7) == g) v = p.ev_pool_w[(((size_t)i * 4 + g) * 128 + (k & 127)) * 128 + (n & 127)] * p.ev_pool_scale[i * 512 + n];
          dst[e] = f2bf(v);
        }
      }
    }
  }
}

__device__ __forceinline__ void row_phase(const Params& p, const bool HAS_Y, const bool HAS_H, int nrows, const u16* __restrict__ Y,
                          const float* __restrict__ modg  , int gate_chunk, const float* __restrict__ gy,
                          const float* __restrict__ gx, const float* __restrict__ modh  , int shift_chunk,
                          u16* __restrict__ H, const bool x_in  ) {
  const int TIDX = opaque_tid(); const int BIDX = opaque_bid();
  const int lane = TIDX & 63;
  const int gw = BIDX * NWV + (TIDX >> 6), nw = gridDim.x * NWV;
  const int rpw = (nrows + nw - 1) / nw;
  const int r_begin = gw * rpw, r_end = min(r_begin + rpw, nrows);
  float* XC = (float*)(p.ws + B_XC);
  float4 gyv[4], gxv[4], gtv[4], shv[4], scv[4];
#pragma unroll
  for (int i = 0; i < 4; ++i) {
    gyv[i] = HAS_Y ? *(const float4*)(gy + i * 256 + lane * 4) : float4{0.f, 0.f, 0.f, 0.f};
    gxv[i] = HAS_H ? *(const float4*)(gx + i * 256 + lane * 4) : float4{0.f, 0.f, 0.f, 0.f};
    gtv[i] = shv[i] = scv[i] = float4{0.f, 0.f, 0.f, 0.f};
  }
  int bcur = -1;
#pragma unroll 1
  for (int row = r_begin; row < r_end; ++row) {
    const int b = row < ML ? (row >> 12) : 8;
    if (b != bcur) {
      bcur = b;
#pragma unroll
      for (int i = 0; i < 4; ++i) {
        const int c = i * 256 + lane * 4;
        if (HAS_Y) gtv[i] = *(const float4*)(modg + (size_t)b * 6144 + gate_chunk * 1024 + c);
        if (HAS_H) {
          shv[i] = *(const float4*)(modh + (size_t)b * 6144 + shift_chunk * 1024 + c);
          scv[i] = *(const float4*)(modh + (size_t)b * 6144 + (shift_chunk + 1) * 1024 + c);
        }
      }
    }
    float* xr = row < ML ? p.out + (size_t)row * D : XC + (size_t)(row - ML) * D;
    float4 xv[4];
    const float* xsrc = x_in ? (row < ML ? p.x + (size_t)row * D : p.ctx + (size_t)(row - ML) * D) : xr;
    if (HAS_Y) {
#pragma unroll
      for (int i = 0; i < 4; ++i) xv[i] = *(const float4*)(xsrc + i * 256 + lane * 4);
      float yv[16];
      float ss = 0.f;
#pragma unroll
      for (int i = 0; i < 4; ++i) {
        u16x4 t = *(const u16x4*)(Y + (size_t)row * D + i * 256 + lane * 4);
#pragma unroll
        for (int e = 0; e < 4; ++e) { yv[i * 4 + e] = bf2f(t[e]); ss += yv[i * 4 + e] * yv[i * 4 + e]; }
      }
      ss = wave_sum(ss);
      float rstd = rsqrtf(ss * (1.f / D) + RMS_EPS);
#pragma unroll
      for (int i = 0; i < 4; ++i) {
        xv[i].x += gtv[i].x * (yv[i * 4 + 0] * rstd * gyv[i].x);
        xv[i].y += gtv[i].y * (yv[i * 4 + 1] * rstd * gyv[i].y);
        xv[i].z += gtv[i].z * (yv[i * 4 + 2] * rstd * gyv[i].z);
        xv[i].w += gtv[i].w * (yv[i * 4 + 3] * rstd * gyv[i].w);
      }
    } else {
      const float* src = row < ML ? p.x + (size_t)row * D : p.ctx + (size_t)(row - ML) * D;
#pragma unroll
      for (int i = 0; i < 4; ++i) xv[i] = *(const float4*)(src + i * 256 + lane * 4);
    }
    if (HAS_Y) {
#pragma unroll
      for (int i = 0; i < 4; ++i) *(float4*)(xr + i * 256 + lane * 4) = xv[i];
    }
    if (HAS_H) {
      float ss = 0.f;
#pragma unroll
      for (int i = 0; i < 4; ++i) ss += xv[i].x * xv[i].x + xv[i].y * xv[i].y + xv[i].z * xv[i].z + xv[i].w * xv[i].w;
      ss = wave_sum(ss);
      float rstd = rsqrtf(ss * (1.f / D) + RMS_EPS);
#pragma unroll
      for (int i = 0; i < 4; ++i) {
        u16x4 o;
        o[0] = f2bf(xv[i].x * rstd * gxv[i].x * (1.f + scv[i].x) + shv[i].x);
        o[1] = f2bf(xv[i].y * rstd * gxv[i].y * (1.f + scv[i].y) + shv[i].y);
        o[2] = f2bf(xv[i].z * rstd * gxv[i].z * (1.f + scv[i].z) + shv[i].z);
        o[3] = f2bf(xv[i].w * rstd * gxv[i].w * (1.f + scv[i].w) + shv[i].w);
        *(u16x4*)(H + (size_t)row * D + i * 256 + lane * 4) = o;
      }
    }
  }
}

namespace pg8 {
#define PG8_LAS __attribute__((address_space(3)))
typedef unsigned short bf16_t;
typedef short bf16x8 __attribute__((ext_vector_type(8)));
typedef float f32x4 __attribute__((ext_vector_type(4)));
typedef unsigned u32x4 __attribute__((ext_vector_type(4)));
constexpr int BM = 256, BK = 64, HALF = 128, HTB = HALF * BK * 2  , STAGE_BYTES = 8 * HTB, NXCD = 8, WGM = 8;

__host__ __device__ __forceinline__ int lds_byte(int r, int c) { const int st = (r >> 4) * 2 + (c >> 5), rr = r & 15, cc = c & 31, ob = rr * 64 + cc * 2; return st * 1024 + (ob ^ (((ob >> 9) & 1) << 5)); }
__host__ __device__ __forceinline__ void stage_rc(int b, int& R, int& C) { const int st = b / 1024, sb = b % 1024, swz = sb ^ (((sb >> 9) & 1) << 5); R = (st >> 1) * 16 + swz / 64; C = (st & 1) * 32 + (swz % 64) / 2; }
__host__ __device__ __forceinline__ int perm32(int rho) { const int n = rho >> 4, i = rho & 15; return 8 * (i >> 2) + 4 * n + (i & 3); }

struct Unit { int pm, pn; };
struct Gemm { const bf16_t* A; const bf16_t* Bt; int M, N, K; };
__device__ __forceinline__ unsigned cvt_pk_bf16(float lo, float hi) { unsigned r; asm volatile("v_cvt_pk_bf16_f32 %0, %1, %2" : "=v"(r) : "v"(lo), "v"(hi)); return r; }
struct TileOrder {
  int ntn, ntiles, G, vb;
  __device__ __forceinline__ bool next(int i, Unit& u) const {
    const int tile = vb + i * G;
    if (tile >= ntiles) return false;
    const int grp = tile / (8 * ntn), rem = tile - grp * 8 * ntn;
    u.pn = rem >> 3; u.pm = grp * 8 + (rem & 7);
    return true;
  }
  __device__ __forceinline__ void a_ready(const Unit&) const {}
  __device__ __forceinline__ void done(const Unit&) const {}
};
struct EpiStoreBf16 {
  static constexpr bool PERM = true, AFTER_DRAIN = false;
  bf16_t* O; int ldc;
  __device__ __forceinline__ void operator()(const f32x4 (&acc)[2][2][4][2], const Unit& u, int wr, int wc, int fr, int fq) const {
    const int row0 = u.pm * BM + wr * 64 + fr, col0 = u.pn * BM + wc * 32 + 8 * fq;
#pragma unroll
    for (int ai = 0; ai < 2; ++ai)
#pragma unroll
      for (int m = 0; m < 4; ++m) {
        bf16_t* rowp = O + (size_t)(row0 + ai * HALF + m * 16) * ldc + col0;
#pragma unroll
        for (int bj = 0; bj < 2; ++bj) {
          const f32x4 v0 = acc[ai][bj][m][0], v1 = acc[ai][bj][m][1];
          u32x4 w; w.x = cvt_pk_bf16(v0[0], v0[1]); w.y = cvt_pk_bf16(v0[2], v0[3]); w.z = cvt_pk_bf16(v1[0], v1[1]); w.w = cvt_pk_bf16(v1[2], v1[3]);
          *(u32x4*)(rowp + bj * HALF) = w;
        }
      }
  }
};
struct EpiFfnConv {
  static constexpr bool PERM = true, AFTER_DRAIN = false;
  bf16_t* O; const float* cw; PG8_LAS float* X;
  __device__ __forceinline__ void operator()(const f32x4 (&acc)[2][2][4][2], const Unit& u, int wr, int wc, int fr, int fq) const {
    const int chl = 32 * wc + 8 * fq, ch0 = u.pn * 128 + chl;
    f32x4 w0[2], w1[2], w2[2];
#pragma unroll
    for (int n = 0; n < 2; ++n) {
      w0[n] = *(const f32x4*)(cw + ch0 + 4 * n); w1[n] = *(const f32x4*)(cw + DFF + ch0 + 4 * n); w2[n] = *(const f32x4*)(cw + 2 * DFF + ch0 + 4 * n);
    }
    const bool ctx = u.pm >= ML / 256;
    if (ctx) {
#pragma unroll
      for (int ai = 0; ai < 2; ++ai) {
        const int bnd = 2 * ai + wr;
        const int dump = 1024 + (fq * 16 + fr) * 8;
        const int a_first = (fr == 0) ? (bnd * 2 + 0) * 128 + chl : dump;
        const int a_last = (fr == 15) ? (bnd * 2 + 1) * 128 + chl : dump;
        *(PG8_LAS f32x4*)(X + a_first) = acc[ai][0][0][0]; *(PG8_LAS f32x4*)(X + a_first + 4) = acc[ai][0][0][1];
        *(PG8_LAS f32x4*)(X + a_last) = acc[ai][0][3][0]; *(PG8_LAS f32x4*)(X + a_last + 4) = acc[ai][0][3][1];
      }
      asm volatile("s_waitcnt lgkmcnt(0)" ::: "memory");
      __builtin_amdgcn_s_barrier();
      __builtin_amdgcn_s_barrier();
    }
#pragma unroll
    for (int ai = 0; ai < 2; ++ai) {
      const int bnd = 2 * ai + wr;
      f32x4 ep[2], en[2];
#pragma unroll
      for (int n = 0; n < 2; ++n) { ep[n] = (f32x4){0.f, 0.f, 0.f, 0.f}; en[n] = (f32x4){0.f, 0.f, 0.f, 0.f}; }
      if (ctx) {
        if (bnd > 0) { ep[0] = *(const PG8_LAS f32x4*)(X + ((bnd - 1) * 2 + 1) * 128 + chl); ep[1] = *(const PG8_LAS f32x4*)(X + ((bnd - 1) * 2 + 1) * 128 + chl + 4); }
        if (bnd < 3) { en[0] = *(const PG8_LAS f32x4*)(X + ((bnd + 1) * 2 + 0) * 128 + chl); en[1] = *(const PG8_LAS f32x4*)(X + ((bnd + 1) * 2 + 0) * 128 + chl + 4); }
      }
#pragma unroll
      for (int m = 0; m < 4; ++m) {
        float o[8];
#pragma unroll
        for (int n = 0; n < 2; ++n)
#pragma unroll
          for (int e = 0; e < 4; ++e) {
            const float a = acc[ai][0][m][n][e];
            const float up = (m > 0) ? acc[ai][0][m > 0 ? m - 1 : 0][n][e] : ep[n][e];
            const float dn = (m < 3) ? acc[ai][0][m < 3 ? m + 1 : 3][n][e] : en[n][e];
            const float pv = dppf<0x121>(fr == 15 ? up : a);
            const float nv = dppf<0x12F>(fr == 0 ? dn : a);
            const float cv = w0[n][e] * pv + w1[n][e] * a + w2[n][e] * nv;
            o[n * 4 + e] = siluf_(cv) * acc[ai][1][m][n][e];
          }
        u32x4 w; w.x = cvt_pk_bf16(o[0], o[1]); w.y = cvt_pk_bf16(o[2], o[3]); w.z = cvt_pk_bf16(o[4], o[5]); w.w = cvt_pk_bf16(o[6], o[7]);
        *(u32x4*)(O + (size_t)(u.pm * BM + ai * HALF + wr * 64 + m * 16 + fr) * DFF + ch0) = w;
      }
    }
  }
};
template <class Epi, class Sched, bool STAMP = false>
__device__ __forceinline__ void gemm_phase(PG8_LAS unsigned char* lds, const Gemm g, const Sched& S, const Epi& E, unsigned long long* stamps) {
    const int tid = opaque_tid(), wid = __builtin_amdgcn_readfirstlane(tid >> 6), lane = tid & 63, wr = wid >> 2, wc = wid & 3, fr = lane & 15, fq = lane >> 4;
    const int K = g.K, nt = K / BK;
    int ts_lo = 0, ts_hi = 0, nts = 0; const unsigned long long rt_entry = STAMP ? (unsigned long long)0 : 0ull;
#define PG8_STAMP() do { if (STAMP && wid == 0 && nts < 64) { const unsigned long long _c = (unsigned long long)clock64(); \
        ts_lo = (lane == nts) ? (int)(unsigned)_c : ts_lo; ts_hi = (lane == nts) ? (int)(unsigned)(_c >> 32) : ts_hi; ++nts; } } while (0)
    PG8_STAMP();
    unsigned voffA[2], voffB[2];
#pragma unroll
    for (int i = 0; i < 2; ++i) { int R, C; stage_rc(tid * 16 + i * 8192, R, C); const int Rb = Epi::PERM ? ((R & ~31) + perm32(R & 31)) : R;
        voffA[i] = (unsigned)(R * K + C) * 2u; voffB[i] = (unsigned)(Rb * K + C) * 2u; }
    const size_t kstep = (size_t)(BK * 2);
    const size_t hstep = (size_t)HALF * K * 2;
    const size_t tstep = 2 * hstep;
    const unsigned ldsw = (unsigned)wid * 1024u;
    const int aoff = lds_byte(wr * 64 + fr, fq * 8), boff = lds_byte(wc * 32 + fr, fq * 8);
#define PG8_SA(b, h) (((b) * 2 + (h)) * HTB)
#define PG8_SB(b, h) ((4 + (b) * 2 + (h)) * HTB)
#define PG8_STAGE(bufoff, gbase, voff) do { _Pragma("unroll") for (int _i = 0; _i < 2; ++_i) \
        __builtin_amdgcn_global_load_lds((const unsigned*)((const char*)(gbase) + (voff)[_i]), (PG8_LAS unsigned*)(lds + (bufoff) + ldsw + _i * 8192), 16, 0, 0); } while (0)
#define PG8_LDA(dst, b, h) do { _Pragma("unroll") for (int m = 0; m < 4; ++m) _Pragma("unroll") for (int k = 0; k < 2; ++k) dst[m][k] = *(const PG8_LAS bf16x8*)(lds + PG8_SA(b, h) + aoff + m * 2048 + k * 1024); } while (0)
#define PG8_LDB(dst, b, h) do { _Pragma("unroll") for (int n = 0; n < 2; ++n) _Pragma("unroll") for (int k = 0; k < 2; ++k) dst[n][k] = *(const PG8_LAS bf16x8*)(lds + PG8_SB(b, h) + boff + n * 2048 + k * 1024); } while (0)
#define PG8_MMA(ai, bj, At, Bt) do { __builtin_amdgcn_s_setprio(1); _Pragma("unroll") for (int m = 0; m < 4; ++m) _Pragma("unroll") for (int n = 0; n < 2; ++n) _Pragma("unroll") for (int k = 0; k < 2; ++k) \
        acc[ai][bj][m][n] = __builtin_amdgcn_mfma_f32_16x16x32_bf16(Bt[n][k], At[m][k], acc[ai][bj][m][n], 0, 0, 0); __builtin_amdgcn_s_setprio(0); } while (0)
#define PG8_WAIT_V(n) asm volatile("s_waitcnt vmcnt(" #n ")" ::: "memory")
#define PG8_WAIT_L(n) asm volatile("s_waitcnt lgkmcnt(" #n ")" ::: "memory")
#define PG8_BAR __builtin_amdgcn_s_barrier()
#define PG8_SCHED __builtin_amdgcn_sched_barrier(0)
    Unit cur, nxt; int ui = 0;
    if (!S.next(0, cur)) return;
    f32x4 acc[2][2][4][2];
#pragma unroll
    for (int a = 0; a < 2; ++a)
#pragma unroll
        for (int b = 0; b < 2; ++b)
#pragma unroll
            for (int m = 0; m < 4; ++m)
#pragma unroll
                for (int n = 0; n < 2; ++n) acc[a][b][m][n] = (f32x4){0.f, 0.f, 0.f, 0.f};
    bf16x8 At[4][2], B0[2][2], B1[2][2];
    const char* cA = (const char*)g.A + (size_t)cur.pm * tstep; const char* cB = (const char*)g.Bt + (size_t)cur.pn * tstep;
    S.a_ready(cur);
    PG8_STAGE(PG8_SB(0, 0), cB, voffB); PG8_STAGE(PG8_SA(0, 0), cA, voffA); PG8_STAGE(PG8_SB(0, 1), cB + hstep, voffB); PG8_STAGE(PG8_SA(0, 1), cA + hstep, voffA);
    if (wr == 1) PG8_BAR;
    PG8_WAIT_V(4); PG8_BAR;
    PG8_STAGE(PG8_SB(1, 0), cB + kstep, voffB); PG8_STAGE(PG8_SA(1, 0), cA + kstep, voffA); PG8_STAGE(PG8_SB(1, 1), cB + hstep + kstep, voffB);
    PG8_WAIT_V(6); PG8_BAR;
    PG8_STAMP();
    for (;;) {
        const bool has_next = S.next(ui + 1, nxt);
        const char* nA = has_next ? (const char*)g.A + (size_t)nxt.pm * tstep : cA; const char* nB = has_next ? (const char*)g.Bt + (size_t)nxt.pn * tstep : cB;
        for (int t = 0; t < nt; t += 2) {
            const bool last = (t == nt - 2);
            const char* a1 = cA + (size_t)(t + 1) * kstep;
            const char* a2 = last ? nA : cA + (size_t)(t + 2) * kstep; const char* b2 = last ? nB : cB + (size_t)(t + 2) * kstep;
            const char* a3 = a2 + kstep; const char* b3 = b2 + kstep;
            if (last && has_next) S.a_ready(nxt);
            PG8_LDB(B0, 0, 0); PG8_SCHED; PG8_LDA(At, 0, 0); PG8_STAGE(PG8_SA(1, 1), a1 + hstep, voffA);
            PG8_WAIT_L(8); PG8_BAR; PG8_WAIT_L(0); PG8_MMA(0, 0, At, B0); PG8_BAR; PG8_SCHED;
            PG8_LDB(B1, 0, 1); PG8_STAGE(PG8_SB(0, 0), b2, voffB);
            PG8_BAR; PG8_WAIT_L(0); PG8_MMA(0, 1, At, B1); PG8_BAR;
            PG8_LDA(At, 0, 1); PG8_STAGE(PG8_SA(0, 0), a2, voffA);
            PG8_BAR; PG8_WAIT_L(0); PG8_MMA(1, 0, At, B0); PG8_BAR; PG8_SCHED;
            PG8_STAGE(PG8_SB(0, 1), b2 + hstep, voffB);
            PG8_WAIT_V(6); PG8_BAR; PG8_MMA(1, 1, At, B1); PG8_BAR;
            PG8_LDB(B0, 1, 0); PG8_SCHED; PG8_LDA(At, 1, 0); PG8_STAGE(PG8_SA(0, 1), a2 + hstep, voffA);
            PG8_WAIT_L(8); PG8_BAR; PG8_WAIT_L(0); PG8_MMA(0, 0, At, B0); PG8_BAR; PG8_SCHED;
            PG8_LDB(B1, 1, 1); PG8_STAGE(PG8_SB(1, 0), b3, voffB);
            PG8_BAR; PG8_WAIT_L(0); PG8_MMA(0, 1, At, B1); PG8_BAR;
            PG8_LDA(At, 1, 1); PG8_STAGE(PG8_SA(1, 0), a3, voffA);
            PG8_BAR; PG8_WAIT_L(0); PG8_MMA(1, 0, At, B0); PG8_BAR; PG8_SCHED;
            PG8_STAGE(PG8_SB(1, 1), b3 + hstep, voffB);
            PG8_WAIT_V(6); PG8_BAR; PG8_MMA(1, 1, At, B1); PG8_BAR;
        }
        PG8_STAMP();
        if constexpr (!Epi::AFTER_DRAIN) { E(acc, cur, wr, wc, fr, fq); S.done(cur); }
        PG8_STAMP();
        if (!has_next) break;
#pragma unroll
        for (int a = 0; a < 2; ++a)
#pragma unroll
            for (int b = 0; b < 2; ++b)
#pragma unroll
                for (int m = 0; m < 4; ++m)
#pragma unroll
                    for (int n = 0; n < 2; ++n) acc[a][b][m][n] = (f32x4){0.f, 0.f, 0.f, 0.f};
        cur = nxt; cA = nA; cB = nB; ++ui;
    }
    PG8_WAIT_V(0);
    if (wr == 0) PG8_BAR;
    PG8_BAR;
    if constexpr (Epi::AFTER_DRAIN) { E.fused(acc, cur, wr, wc, fr, fq, lds, wid, lane); S.done(cur); }
    PG8_STAMP();
    if (STAMP && wid == 0) { stamps[lane] = lane < nts ? (((unsigned long long)(unsigned)ts_hi << 32) | (unsigned)ts_lo) : 0ull;
        if (lane == 62) stamps[62] = rt_entry; if (lane == 63) stamps[63] = (unsigned long long)0; }
#undef PG8_STAMP
#undef PG8_SA
#undef PG8_SB
#undef PG8_STAGE
#undef PG8_LDA
#undef PG8_LDB
#undef PG8_MMA
#undef PG8_WAIT_V
#undef PG8_WAIT_L
#undef PG8_BAR
#undef PG8_SCHED
}
}

enum { EPI_BF16 = 0, EPI_FFN = 1, EPI_ODD = 2, EPI_LORA = 3 };

struct GemmP {
  const u16* A1; const u16* A2; int lda1, lda2, ksplit;
  const u16* Bt; int K; int ntn; int mtiles; int conv;
  u16* C; int ldc;
  const float* cw;
  int cwC;
  const float* w0; const float* a0; h16* lout;
};

__device__ __forceinline__ bool seg_start(int a) { return a < ML ? ((a & 63) == 0) : (((a - ML) & 255) == 0); }
__device__ __forceinline__ bool seg_end(int a) { return a < ML ? ((a & 63) == 63) : (((a - ML) & 255) == 255); }

#define RAW_BARRIER() do { asm volatile("s_waitcnt lgkmcnt(0)" ::: "memory"); __builtin_amdgcn_s_barrier(); } while (0)
constexpr int GSTAGE = 65536;
constexpr int NSTG = 2;
constexpr int SMEM_BYTES = NSTG * GSTAGE;

template <int NT, int EPI>
__device__ __forceinline__ void gemm_phase(const GemmP& g, char* smem) {
  const int TIDX = opaque_tid(); const int BIDX = opaque_bid(); (void)TIDX; (void)BIDX;
  constexpr int BN = 64 * NT;
  const int tid = TIDX, wid = tid >> 6, lane = tid & 63, wr = wid >> 2, wc = wid & 3, fr = lane & 15, fq = lane >> 4;
  const int ntiles = g.mtiles * g.ntn;
  const int sr = tid >> 3;
  const int scol = ((tid & 7) ^ ((sr >> 1) & 7)) * 8;
  const int sw0 = ((fq) ^ (fr >> 1)) * 8, sw1 = ((4 + fq) ^ (fr >> 1)) * 8;
#pragma unroll 1
  for (int tile = vblock(BIDX); tile < ntiles; tile += gridDim.x) {
    int grp_ = tile / (8 * g.ntn), rem_ = tile - grp_ * 8 * g.ntn;
    int nt = rem_ >> 3, mt = grp_ * 8 + (rem_ & 7);
    const int row0 = mt * 256;
    const int n0 = nt * BN;
    f32x4 acc[8][NT];
#pragma unroll
    for (int m = 0; m < 8; ++m)
#pragma unroll
      for (int n = 0; n < NT; ++n) acc[m][n] = f32x4{0.f, 0.f, 0.f, 0.f};
    const int kt0 = (EPI == EPI_LORA) ? (nt < 4 ? 0 : (nt < 6 ? 1 : (nt < 8 ? 2 : 3))) : 0;
    const int nk = (EPI == EPI_LORA) ? (nt < 8 ? 1 : 2) : (g.K >> 6);
    const u16* bbase = g.Bt + (size_t)nt * (g.K >> 6) * (BN * 64) + tid * 8;
    auto piece = [&](int t, int st, int q) {
      char* base = smem + st * GSTAGE + tid * 16;
      t += kt0;
      int kk = t << 6;
      if (q < 4) {
        const u16* Ab; int lda;
        if (kk < g.ksplit) { Ab = g.A1 + kk; lda = g.lda1; } else { Ab = g.A2 + (kk - g.ksplit); lda = g.lda2; }
        const u16* ap = Ab + (size_t)(row0 + sr + 64 * q) * lda + scol;
        __builtin_amdgcn_global_load_lds((const unsigned*)(ap), (unsigned*)(base + q * 8192), 16, 0, 0);
      } else {
        const int qq = (NT == 3 && q == 7) ? 2 : q - 4;
        __builtin_amdgcn_global_load_lds((const unsigned*)(bbase + (size_t)t * (BN * 64) + qq * 4096), (unsigned*)(base + 32768 + (q - 4) * 8192), 16, 0, 0);
      }
    };
    auto issue = [&](int t, int st) {
#pragma unroll
      for (int q = 0; q < 8; ++q) piece(t, st, q);
    };
    issue(0, 0);
#pragma unroll 1
    for (int t = 0; t < nk; ++t) {
      const int st = t & 1;
      asm volatile("s_waitcnt vmcnt(0)" ::: "memory");
      RAW_BARRIER();
      const bool more = t + 1 < nk;
      const u16* SA = (const u16*)(smem + st * GSTAGE);
      const u16* SB = (const u16*)(smem + st * GSTAGE + 32768);
      const u16* pa = SA + (wr * 128 + fr) * 64;
      const u16* pb = SB + (wc * 16 * NT + fr) * 64;
      bf16x8 Ac[4], An[4], Bc[NT], Bn[NT];
#pragma unroll
      for (int n = 0; n < NT; ++n) Bc[n] = *(const bf16x8*)(pb + n * 16 * 64 + sw0);
#pragma unroll
      for (int m = 0; m < 4; ++m) Ac[m] = *(const bf16x8*)(pa + m * 16 * 64 + sw0);
#pragma unroll
      for (int u = 0; u < 4; ++u) {
        const int mh = u & 1;
        if (u < 3) {
          const int nmh = (u + 1) & 1, nsw = ((u + 1) >> 1) ? sw1 : sw0;
#pragma unroll
          for (int m = 0; m < 4; ++m) An[m] = *(const bf16x8*)(pa + (nmh * 64 + m * 16) * 64 + nsw);
        }
        if (u == 1) {
#pragma unroll
          for (int n = 0; n < NT; ++n) Bn[n] = *(const bf16x8*)(pb + n * 16 * 64 + sw1);
        }
#pragma unroll
        for (int m = 0; m < 4; ++m) {
#pragma unroll
          for (int n = 0; n < NT; ++n)
            acc[mh * 4 + m][n] = __builtin_amdgcn_mfma_f32_16x16x32_bf16(Ac[m], Bc[n], acc[mh * 4 + m][n], 0, 0, 0);
          if (u < 2) {
            if (more) piece(t + 1, st ^ 1, u * 4 + m);
          }
        }
        if (u < 3) {
#pragma unroll
          for (int m = 0; m < 4; ++m) Ac[m] = An[m];
        }
        if (u == 1) {
#pragma unroll
          for (int n = 0; n < NT; ++n) Bc[n] = Bn[n];
        }
      }
    }
    __syncthreads();
    if (EPI == EPI_BF16) {
#pragma unroll
      for (int m = 0; m < 8; ++m)
#pragma unroll
        for (int j = 0; j < 4; ++j) {
          int r = wr * 128 + m * 16 + fq * 4 + j;
          size_t ro = (size_t)(row0 + r) * g.ldc + n0 + wc * 16 * NT + fr;
#pragma unroll
          for (int n = 0; n < NT; ++n) g.C[ro + n * 16] = f2bf(acc[m][n][j]);
        }
    } else if (EPI == EPI_LORA) {
      const int seg = n0 >> 9;
      h16* dst = g.lout + (size_t)seg * MT * 512 + (size_t)row0 * 512 + (n0 & 511) + wc * 16 * NT + fr;
      float bias[NT];
#pragma unroll
      for (int n = 0; n < NT; ++n) {
        int cc = (n0 & 511) + wc * 16 * NT + n * 16 + fr;
        bias[n] = seg < 2 ? g.w0[seg * 512 + cc] : (seg < 4 ? g.a0[(seg - 2) * 512 + cc] : 0.f);
      }
      const bool odd = (fr & 1) != 0;
      auto lora_store = [&](auto fn) {
        unsigned ro = (unsigned)(wr * 128 + fq * 4) * 512;
#pragma unroll
        for (int m = 0; m < 8; ++m) {
          asm volatile("" : "+v"(ro));
#pragma unroll
          for (int n = 0; n < NT; ++n)
#pragma unroll
            for (int jp = 0; jp < 2; ++jp) {
              const float va = fn(acc[m][n][2 * jp] + bias[n]), vb2 = fn(acc[m][n][2 * jp + 1] + bias[n]);
              const float recv = dppf<0xB1>(odd ? va : vb2);
              const h16 lo = (h16)(odd ? recv : va), hi = (h16)(odd ? vb2 : recv);
              const unsigned pk = (unsigned)__builtin_bit_cast(unsigned short, lo) | ((unsigned)__builtin_bit_cast(unsigned short, hi) << 16);
              *(unsigned*)(dst + ro + (2 * jp + (odd ? 1 : 0)) * 512 + n * 16 - (odd ? 1 : 0)) = pk;
            }
          ro += 16 * 512;
          __syncthreads();
        }
      };
      if (seg < 2) {
        lora_store([](float v) { return -0.60653066f * sigmoidf_(v); });
      } else if (seg < 4) {
        lora_store([](float v) { return sigmoidf_(v); });
      } else {
        lora_store([](float v) { return v; });
      }
    } else {
      constexpr int CW = (EPI == EPI_FFN) ? 128 : 64;
      constexpr int CPW = CW / 4;
      constexpr int NA = CPW / 16;
      float* sC = (float*)smem;
      constexpr int LDC = (EPI == EPI_FFN) ? DFF : D;
      const int colofs = wc * CPW + fr;
      {
        float* sb = sC + (wr * 128 + fq * 4) * CW + colofs;
#pragma unroll
        for (int m = 0; m < 8; ++m)
#pragma unroll
          for (int n = 0; n < NA; ++n)
#pragma unroll
            for (int j = 0; j < 4; j += 3) {
              float u = (EPI == EPI_FFN) ? acc[m][n][j] : acc[m][1][j] * acc[m][2][j];
              sb[(m * 16 + j) * CW + n * 16] = u;
            }
      }
      __syncthreads();
      float cwv[NA][3];
#pragma unroll
      for (int n = 0; n < NA; ++n) {
        int ch = nt * CW + colofs + n * 16;
        cwv[n][0] = g.cw[ch]; cwv[n][1] = g.cw[g.cwC + ch]; cwv[n][2] = g.cw[2 * g.cwC + ch];
      }
      const bool lat = row0 < ML;
      const int segmask = lat ? 63 : 255;
      u16* const sO = (u16*)(smem + GSTAGE);
      int rb = wr * 128 + fq * 4;
#pragma unroll
      for (int m = 0; m < 8; ++m) {
        asm volatile("" : "+v"(rb));
        const int so = rb * CW + colofs;
#pragma unroll
        for (int n = 0; n < NA; ++n) {
          float c4[4];
#pragma unroll
          for (int j = 0; j < 4; ++j) c4[j] = (EPI == EPI_FFN) ? acc[m][n][j] : acc[m][1][j] * acc[m][2][j];
          const float pv0 = sC[max(so - CW, 0) + n * 16];
          const float nv3 = sC[min(so + 4 * CW, 255 * CW + colofs) + n * 16];
#pragma unroll
          for (int j = 0; j < 4; ++j) {
            const int r = rb + j;
            float pv = (j == 0) ? pv0 : c4[j - 1];
            float nv = (j == 3) ? nv3 : c4[j + 1];
            pv = ((r & segmask) == 0) ? 0.f : pv;
            nv = ((r & segmask) == segmask) ? 0.f : nv;
            const float cv = cwv[n][0] * pv + cwv[n][1] * c4[j] + cwv[n][2] * nv;
            const float o = (EPI == EPI_FFN) ? siluf_(cv) * acc[m][n + 2][j] : acc[m][0][j] * cv;
            sO[(rb + j) * CW + colofs + n * 16] = f2bf(o);
          }
        }
        rb += 16;
        __syncthreads();
      }
      {
        constexpr int CH8 = CW / 8;
#pragma unroll
        for (int q = 0; q < (256 * CH8) / NTHR; ++q) {
          const int c = tid + NTHR * q, row = c / CH8, col8 = (c % CH8) * 8;
          const u16x8 v = *(const u16x8*)(sO + row * CW + col8);
          *(u16x8*)(g.C + (size_t)(row0 + row) * LDC + nt * CW + col8) = v;
        }
      }
      __syncthreads();
    }
  }
}

using f16x8 = __attribute__((ext_vector_type(8))) _Float16;
__device__ __forceinline__ void prep1_phase(const Params& p, int i, int nrows, const u16* __restrict__ P, h16* __restrict__ R,
                                            h16* __restrict__ Kk, h16* __restrict__ V, u16* __restrict__ L, u16* __restrict__ Dp) {
  const int TIDX = opaque_tid(); const int BIDX = opaque_bid();
  const int lane = TIDX & 63;
  const int gw = BIDX * NWV + (TIDX >> 6), nw = gridDim.x * NWV;
  const float* mu0 = p.ev_mu + (size_t)i * 2 * DPROJ;
  const float* mu1 = mu0 + DPROJ;
  float* KINV = (float*)(p.ws + B_KINV);
  float m0[3][8], m1[3][8], kkp[8], lm0[8], lm1[8];
#pragma unroll
  for (int q = 0; q < 3; ++q)
#pragma unroll
    for (int e = 0; e < 8; ++e) { int c = (lane + 64 * q) * 8 + e; m0[q][e] = mu0[c]; m1[q][e] = mu1[c]; }
#pragma unroll
  for (int e = 0; e < 8; ++e) kkp[e] = p.ev_k_k[i * 512 + lane * 8 + e];
  const int ll = lane < 36 ? lane : 35;
#pragma unroll
  for (int e = 0; e < 8; ++e) { lm0[e] = mu0[1536 + ll * 8 + e]; lm1[e] = mu1[1536 + ll * 8 + e]; }
  const int gi = lane >> 4, half = 1 << gi;
  const u16x8 zero8 = {0, 0, 0, 0, 0, 0, 0, 0};
  const int rpw = (nrows + nw - 1) / nw;
  const int r_begin = gw * rpw, r_end = min(r_begin + rpw, nrows);
  u16x8 cur[3], pv[3], nv[3], lc, lp, ln;
  float wsum[8];
#pragma unroll
  for (int e = 0; e < 8; ++e) wsum[e] = 0.f;
#pragma unroll 1
  for (int row = r_begin; row < r_end; ++row) {
    const bool lat = row < ML;
    const int t = lat ? (row & 4095) : ((row - ML) & 255);
    const int tl = lat ? 4095 : 255;
    const bool hp = t > 0, hn = t < tl;
    const u16* pc = P + (size_t)row * NEVP;
    const u16* pn = (row + 1 < MT) ? pc + NEVP : pc;
    if (row == r_begin) {
      const u16* pp = row > 0 ? pc - NEVP : pc;
#pragma unroll
      for (int q = 0; q < 3; ++q) { int c = (lane + 64 * q) * 8; cur[q] = *(const u16x8*)(pc + c); pv[q] = *(const u16x8*)(pp + c); }
      lc = *(const u16x8*)(pc + 1536 + ll * 8); lp = *(const u16x8*)(pp + 1536 + ll * 8);
    } else {
#pragma unroll
      for (int q = 0; q < 3; ++q) { pv[q] = cur[q]; cur[q] = nv[q]; }
      lp = lc; lc = ln;
    }
#pragma unroll
    for (int q = 0; q < 3; ++q) nv[q] = *(const u16x8*)(pn + (lane + 64 * q) * 8);
    ln = *(const u16x8*)(pn + 1536 + ll * 8);
    const int pos = lat ? (row & 63) : ((row - ML) & 255);
    const int Lr = lat ? 64 : 256;
    const u16* pool = pc + DPROJ + lane * 8;
    const u16x8 pcen = *(const u16x8*)(pool);
    if (row == r_begin || pos == 0) {
#pragma unroll
      for (int e = 0; e < 8; ++e) wsum[e] = 0.f;
#pragma unroll
      for (int dd = 0; dd < 16; ++dd) {
        const int d = dd - 8, jj = pos + d;
        const int jc = min(max(jj, 0), Lr - 1);
        const u16x8 w8 = *(const u16x8*)(pool + (ptrdiff_t)(jc - pos) * NEVP);
        const bool ok = d >= -half && d < half && jj >= 0 && jj < Lr;
        const float mk = ok ? 1.f : 0.f;
#pragma unroll
        for (int e = 0; e < 8; ++e) wsum[e] += mk * bf2f(w8[e]);
      }
    } else {
      const int ja = pos + half - 1, jr = pos - 1 - half;
      const int jac = min(ja, Lr - 1), jrc = max(jr, 0);
      const u16x8 wa = *(const u16x8*)(pool + (ptrdiff_t)(jac - pos) * NEVP);
      const u16x8 wr8 = *(const u16x8*)(pool + (ptrdiff_t)(jrc - pos) * NEVP);
      const float ma = (ja <= Lr - 1) ? 1.f : 0.f, mr = (jr >= 0) ? 1.f : 0.f;
#pragma unroll
      for (int e = 0; e < 8; ++e) wsum[e] += ma * bf2f(wa[e]) - mr * bf2f(wr8[e]);
    }
    float ssq = 0.f;
#pragma unroll
    for (int q = 0; q < 3; ++q) {
      f16x8 o;
#pragma unroll
      for (int e = 0; e < 8; ++e) {
        float c = bf2f(cur[q][e]);
        float a = hp ? bf2f(pv[q][e]) : 0.f;
        float n = hn ? bf2f(nv[q][e]) : 0.f;
        float sv = c + m0[q][e] * (a - c) + m1[q][e] * (n - c);
        o[e] = (h16)sv;
        if (q == 1) { float kr = sv * kkp[e]; ssq += kr * kr; }
      }
      h16* dst = q == 0 ? R : (q == 1 ? Kk : V);
      *(f16x8*)(dst + (size_t)row * 512 + lane * 8) = o;
    }
    ssq += __shfl_xor(ssq, 1);
    ssq += __shfl_xor(ssq, 2);
    ssq += __shfl_xor(ssq, 4);
    if ((lane & 7) == 0) KINV[(size_t)row * 8 + (lane >> 3)] = rsqrtf(fmaxf(ssq, 1e-24f));
    if (lane < 48) {
      u16x8 o = zero8;
      if (lane < 36) {
#pragma unroll
        for (int e = 0; e < 8; ++e) {
          float c = bf2f(lc[e]);
          float a = hp ? bf2f(lp[e]) : 0.f;
          float n = hn ? bf2f(ln[e]) : 0.f;
          float sv = c + lm0[e] * (a - c) + lm1[e] * (n - c);
          float ov = lane < 8 ? (1.f - 2.f * __builtin_amdgcn_rcpf(1.f + __expf(2.f * sv))) : (lane < 24 ? sv : sigmoidf_(sv));
          o[e] = f2bf(ov);
        }
      }
      *(u16x8*)(L + (size_t)row * LORA_K + lane * 8) = o;
    }
    {
      int lo = max(pos - half, 0), hi = min(pos + half, Lr);
      float inv = 1.f / (float)(hi - lo);
      u16x8 o;
#pragma unroll
      for (int e = 0; e < 8; ++e) o[e] = f2bf(wsum[e] * inv - bf2f(pcen[e]));
      *(u16x8*)(Dp + (size_t)row * 512 + lane * 8) = o;
    }
  }
}

__device__ __forceinline__ void scan_phase(const Params& p, int i, const h16* __restrict__ R, const h16* __restrict__ Kk,
                                           const h16* __restrict__ V, const h16* __restrict__ W0, const h16* __restrict__ W1,
                                           const h16* __restrict__ A0, const h16* __restrict__ A1, u16* __restrict__ Y0,
                                           u16* __restrict__ Y1, char* smem) {
  const int TIDX = opaque_tid(); const int BIDX = opaque_bid();
  const int tid = TIDX, wid = tid >> 6, lane = tid & 63;
  const int grp = lane >> 4, j16 = lane & 15;
  const float* KINV = (const float*)(p.ws + B_KINV);
  float* sOp = (float*)smem;
  const bool stager = tid >= 256;
  const int stid = tid & 255;
#pragma unroll 1
  for (int item = BIDX; item < 256; item += gridDim.x) {
    int half = item & 1, dir = (item >> 1) & 1, h = (item >> 2) & 7, b = item >> 5;
    const h16* Wd = dir ? W1 : W0;
    const h16* Ad = dir ? A1 : A0;
    u16* Yd = dir ? Y1 : Y0;
    int ss = stid >> 4, c4 = (stid & 15) * 4;
    float kkp[4], kap[4];
#pragma unroll
    for (int e = 0; e < 4; ++e) { kkp[e] = p.ev_k_k[i * 512 + h * 64 + c4 + e]; kap[e] = p.ev_k_a[i * 512 + h * 64 + c4 + e]; }
    const int rowA = half * 32 + (wid & 3) * 8 + grp * 2;
    f2 S0a = {0.f, 0.f}, S0b = {0.f, 0.f}, S1a = {0.f, 0.f}, S1b = {0.f, 0.f};

    auto tok_row = [&](int cidx, int s) -> int {
      if (cidx < 16) { int q = cidx * 16 + s; int tk = dir ? 255 - q : q; return ML + b * 256 + tk; }
      int q = (cidx - 16) * 16 + s; int tk = dir ? 4095 - q : q; return b * 4096 + tk;
    };
    h16x4 lr, lk, lv, lw, la; float linv;
    auto gload = [&](int cidx) {
      size_t o = (size_t)tok_row(cidx, ss) * 512 + h * 64 + c4;
      lr = *(const h16x4*)(R + o); lk = *(const h16x4*)(Kk + o); lv = *(const h16x4*)(V + o);
      lw = *(const h16x4*)(Wd + o); la = *(const h16x4*)(Ad + o);
      linv = KINV[(size_t)tok_row(cidx, ss) * 8 + h];
    };
    auto lstore = [&](int buf) {
      float* base = sOp + (size_t)buf * 16 * 6 * 64 + ss * 6 * 64 + c4;
      float4 kk4, w4, b4, kd4, r4, v4;
      float* kkf = (float*)&kk4; float* wf = (float*)&w4; float* bfp = (float*)&b4; float* kdf = (float*)&kd4;
      float* rf = (float*)&r4; float* vf = (float*)&v4;
#pragma unroll
      for (int e = 0; e < 4; ++e) {
        float k = (float)lk[e], a = (float)la[e];
        float kk = k * kkp[e] * linv;
        kkf[e] = kk;
        wf[e] = __expf((float)lw[e]);
        bfp[e] = kk * a;
        kdf[e] = k * (1.f + (a - 1.f) * kap[e]);
        rf[e] = (float)lr[e];
        vf[e] = (float)lv[e];
      }
      *(float4*)(base + 0 * 64) = kk4; *(float4*)(base + 1 * 64) = w4; *(float4*)(base + 2 * 64) = b4;
      *(float4*)(base + 3 * 64) = kd4; *(float4*)(base + 4 * 64) = r4; *(float4*)(base + 5 * 64) = v4;
    };
    __syncthreads();
    if (stager) { gload(0); lstore(0); }
    __syncthreads();
    constexpr int NCH = 16 + 256;
#pragma unroll 1
    for (int cidx = 0; cidx < NCH; ++cidx) {
      int buf = cidx & 1;
      if (stager) {
        if (cidx + 1 < NCH) { gload(cidx + 1); lstore(buf ^ 1); }
      } else {
        const float* cb = sOp + (size_t)buf * 16 * 6 * 64;
        float qa0[16], qa1[16];
        const float* lb = cb + j16 * 4;
        const float* vb = cb + 5 * 64 + rowA;
        float4 c_kk = *(const float4*)(lb + 0 * 64), c_w = *(const float4*)(lb + 1 * 64), c_b = *(const float4*)(lb + 2 * 64),
               c_kd = *(const float4*)(lb + 3 * 64), c_r = *(const float4*)(lb + 4 * 64);
        float2 c_v = *(const float2*)(vb);
#pragma unroll
        for (int s = 0; s < 16; ++s) {
          float4 n_kk, n_w, n_b, n_kd, n_r; float2 n_v;
          if (s < 15) {
            const float* nb = lb + (s + 1) * 6 * 64;
            n_kk = *(const float4*)(nb + 0 * 64); n_w = *(const float4*)(nb + 1 * 64); n_b = *(const float4*)(nb + 2 * 64);
            n_kd = *(const float4*)(nb + 3 * 64); n_r = *(const float4*)(nb + 4 * 64);
            n_v = *(const float2*)(vb + (s + 1) * 6 * 64);
          }
          const f2 kka = {c_kk.x, c_kk.y}, kkb = {c_kk.z, c_kk.w}, wa = {c_w.x, c_w.y}, wb = {c_w.z, c_w.w};
          const f2 ba = {c_b.x, c_b.y}, bb = {c_b.z, c_b.w}, kda = {c_kd.x, c_kd.y}, kdb = {c_kd.z, c_kd.w};
          const f2 ra = {c_r.x, c_r.y}, rb = {c_r.z, c_r.w};
          f2 t0 = __builtin_elementwise_fma(S0b, kkb, S0a * kka);
          f2 t1 = __builtin_elementwise_fma(S1b, kkb, S1a * kka);
          float sa0 = t0.x + t0.y, sa1 = t1.x + t1.y;
          const f2 v0 = {c_v.x, c_v.x}, v1 = {c_v.y, c_v.y};
          f2 u0a = v0 * kda, u0b = v0 * kdb, u1a = v1 * kda, u1b = v1 * kdb;
          sa0 = row16_sum(sa0);
          sa1 = row16_sum(sa1);
          const f2 ns0 = {-sa0, -sa0}, ns1 = {-sa1, -sa1};
          u0a = __builtin_elementwise_fma(ns0, ba, u0a); u0b = __builtin_elementwise_fma(ns0, bb, u0b);
          u1a = __builtin_elementwise_fma(ns1, ba, u1a); u1b = __builtin_elementwise_fma(ns1, bb, u1b);
          S0a = __builtin_elementwise_fma(S0a, wa, u0a); S0b = __builtin_elementwise_fma(S0b, wb, u0b);
          S1a = __builtin_elementwise_fma(S1a, wa, u1a); S1b = __builtin_elementwise_fma(S1b, wb, u1b);
          f2 q0 = __builtin_elementwise_fma(S0b, rb, S0a * ra);
          f2 q1 = __builtin_elementwise_fma(S1b, rb, S1a * ra);
          qa0[s] = q0.x + q0.y; qa1[s] = q1.x + q1.y;
          if (s < 15) { c_kk = n_kk; c_w = n_w; c_b = n_b; c_kd = n_kd; c_r = n_r; c_v = n_v; }
        }
        const float yk0 = row16_transpose_sum(qa0, j16), yk1 = row16_transpose_sum(qa1, j16);
        size_t o = (size_t)tok_row(cidx, j16) * 512 + h * 64 + rowA;
        unsigned pk = (unsigned)f2bf(yk0) | ((unsigned)f2bf(yk1) << 16);
        *(unsigned*)(Yd + o) = pk;
      }
      __syncthreads();
    }
  }
}

__device__ __forceinline__ float grp8_sum(float x) {
  x += __shfl_xor(x, 1);
  x += __shfl_xor(x, 2);
  x += __shfl_xor(x, 4);
  return x;
}
__device__ __forceinline__ void merge_phase(const Params& p, int i, int nrows, const h16* __restrict__ R, const h16* __restrict__ Kk,
                                            const h16* __restrict__ V, const h16* __restrict__ A0, const h16* __restrict__ A1,
                                            const h16* __restrict__ Gt, const u16* __restrict__ Y0, const u16* __restrict__ Y1,
                                            u16* __restrict__ YC  ) {
  const int TIDX = opaque_tid(); const int BIDX = opaque_bid();
  const int lane = TIDX & 63;
  const int gw = BIDX * NWV + (TIDX >> 6), nw = gridDim.x * NWV;
  float gnw[8], gnb[8], ka[8], rk[8];
#pragma unroll
  for (int e = 0; e < 8; ++e) {
    int c = i * 512 + lane * 8 + e;
    gnw[e] = p.ev_gn_w[c]; gnb[e] = p.ev_gn_b[c]; ka[e] = p.ev_k_a[c]; rk[e] = p.ev_r_k[c];
  }
#pragma unroll 1
  for (int row = gw; row < nrows; row += nw) {
    size_t o = (size_t)row * 512 + lane * 8;
    u16x8 y0 = *(const u16x8*)(Y0 + o), y1 = *(const u16x8*)(Y1 + o);
    f16x8 k8 = *(const f16x8*)(Kk + o), a08 = *(const f16x8*)(A0 + o), a18 = *(const f16x8*)(A1 + o);
    f16x8 r8 = *(const f16x8*)(R + o), v8 = *(const f16x8*)(V + o), g8 = *(const f16x8*)(Gt + o);
    float y[8], s = 0.f, cf = 0.f;
#pragma unroll
    for (int e = 0; e < 8; ++e) {
      y[e] = bf2f(y0[e]) + bf2f(y1[e]);
      s += y[e];
      float kd = (float)k8[e] * (2.f + ((float)a08[e] + (float)a18[e] - 2.f) * ka[e]);
      cf += (float)r8[e] * rk[e] * kd;
    }
    float mean = grp8_sum(s) * (1.f / 64.f);
    cf = grp8_sum(cf);
    float vs = 0.f;
#pragma unroll
    for (int e = 0; e < 8; ++e) { y[e] -= mean; vs += y[e] * y[e]; }
    float rs = rsqrtf(grp8_sum(vs) * (1.f / 64.f) + GN_EPS);
    u16x8 ov;
#pragma unroll
    for (int e = 0; e < 8; ++e) ov[e] = f2bf((y[e] * rs * gnw[e] + gnb[e] + cf * (float)v8[e]) * (float)g8[e]);
    *(u16x8*)(YC + (size_t)row * 1024 + lane * 8) = ov;
  }
}

__device__ __forceinline__ void gemm8_bf16(const GemmP& g, char* smem) {
  const int BIDX = opaque_bid();
  pg8::Gemm gg{g.A1, g.Bt, g.mtiles * 256, g.ntn * 256, g.K};
  pg8::TileOrder S{g.ntn, g.mtiles * g.ntn, (int)gridDim.x, vblock(BIDX)};
  pg8::EpiStoreBf16 E{g.C, g.ldc};
  pg8::gemm_phase<pg8::EpiStoreBf16, pg8::TileOrder, false>((PG8_LAS unsigned char*)smem, gg, S, E, nullptr);
}

__device__ __forceinline__ void gemm8_ffn(const GemmP& g, char* smem) {
  const int BIDX = opaque_bid();
  pg8::Gemm gg{g.A1, g.Bt, g.mtiles * 256, g.ntn * 256, g.K};
  pg8::TileOrder S{g.ntn, g.mtiles * g.ntn, (int)gridDim.x, vblock(BIDX)};
  pg8::EpiFfnConv E{g.C, g.cw, (PG8_LAS float*)(smem + SMEM_BYTES)};
  pg8::gemm_phase<pg8::EpiFfnConv, pg8::TileOrder, false>((PG8_LAS unsigned char*)smem, gg, S, E, nullptr);
}

constexpr int NPHASES = 34;
enum { T_PRE = 0, T_ROW, T_GEMM_BF16, T_PREP1, T_LORA, T_SCAN, T_MERGE, T_FFN, T_ODD };

__global__ void __launch_bounds__(NTHR, 1) mega(Params p, int ph_lo, int ph_hi, int coop) {
  __shared__ __attribute__((aligned(16))) char smem[SMEM_BYTES + 8192];
  cg::grid_group grid = cg::this_grid();
  volatile LAS unsigned* xst = (volatile LAS unsigned*)(smem + SMEM_BYTES + 8176);
  if (threadIdx.x == 0) { xst[0] = 0u; xst[1] = 0u; }
  __syncthreads();
  XcdBarrier xb{};
  if (coop && blockIdx.x == 0) for (int e = threadIdx.x; e < 4096; e += NTHR) ((unsigned*)(p.ws + B_BAR))[e] = 0u;
  bool first_sync = true;
  const u16* W = (const u16*)p.ws;
  const float* MOD = (const float*)(p.ws + B_MOD);
  u16* H = (u16*)ACT(p, 0);
  u16* Y = (u16*)ACT(p, 2);
  u16* G = (u16*)ACT(p, 4);
  u16* P = (u16*)ACT(p, 6);
  h16* Rr = (h16*)ACT(p, 2);
  h16* Kk = (h16*)ACT(p, 3);
  h16* Vv = (h16*)ACT(p, 4);
  u16* Dp = (u16*)ACT(p, 5);
  u16* L = (u16*)ACT(p, 0);
  h16* LO = (h16*)ACT(p, 6);
  u16* Y0 = (u16*)ACT(p, 0);
  u16* Y1 = (u16*)ACT(p, 1);
  u16* YC = (u16*)ACT(p, 6);
  u16* G1 = (u16*)ACT(p, 4);

#pragma unroll 1
  for (int ph = ph_lo; ph < ph_hi; ++ph) {
    int type, l = 0, pos = 0;
    if (ph == 0) type = T_PRE;
    else if (ph == 1) { type = T_ROW; pos = -1; }
    else {
      if (ph < 12) { l = 0; pos = ph - 2; }
      else if (ph < 18) { l = 1; pos = ph - 12; }
      else if (ph < 28) { l = 2; pos = ph - 18; }
      else { l = 3; pos = ph - 28; }
      if (l & 1) pos = pos == 0 ? 10 : (pos == 1 ? 5 : pos + 4);
      type = pos == 0 ? T_GEMM_BF16 : pos == 1 ? T_PREP1 : pos == 2 ? T_LORA : pos == 3 ? T_SCAN : pos == 4 ? T_MERGE
           : pos == 5 ? T_GEMM_BF16 : pos == 6 ? T_ROW : pos == 7 ? T_FFN : pos == 8 ? T_GEMM_BF16 : pos == 9 ? T_ROW : T_ODD;
    }
    const int reps = 1 + ((REP_MASK >> type) & 1);
#pragma unroll 1
    for (int rep = 0; rep < reps; ++rep) {
    const int i = l >> 1;
    const bool even = (l & 1) == 0;
    const bool ctx_later = l < 2;
    const bool ctx_in = l <= 2;
    const float* MODL = MOD + (size_t)l * 9 * 6144;
    const float* gn = p.norm_g + (size_t)l * 4 * D;
    GemmP g{};
    g.conv = 0;
    if (pos == 0) {
      g.A1 = H; g.A2 = H; g.lda1 = D; g.lda2 = D; g.ksplit = D; g.Bt = W + OFF_EVIN + i * SZ_EVIN; g.K = D;
      g.ntn = NEVP / 256; g.mtiles = ctx_in ? 136 : 128; g.C = P; g.ldc = NEVP;
    } else if (pos == 2) {
      g.A1 = L; g.A2 = L; g.lda1 = LORA_K; g.lda2 = LORA_K; g.ksplit = LORA_K; g.Bt = W + OFF_LORA + i * SZ_LORA; g.K = LORA_K;
      g.ntn = LORA_N / 256; g.mtiles = ctx_in ? 136 : 128;
      g.w0 = p.ev_w0 + i * 1024; g.a0 = p.ev_a0 + i * 1024; g.lout = LO;
    } else if (pos == 5) {
      if (even) { g.A1 = YC; g.A2 = YC; g.lda1 = D; g.lda2 = D; g.ksplit = D; g.Bt = W + OFF_EVOUT + i * SZ_SQ; }
      else { g.A1 = G1; g.A2 = G1; g.lda1 = D; g.lda2 = D; g.ksplit = D; g.Bt = W + OFF_ODOUT + i * SZ_SQ; }
      g.K = D; g.ntn = 4; g.mtiles = ctx_later ? 136 : 128; g.C = Y; g.ldc = D;
    } else if (pos == 7) {
      g.A1 = H; g.A2 = H; g.lda1 = D; g.lda2 = D; g.ksplit = D; g.Bt = W + OFF_FFNUP + l * SZ_FFNUP; g.K = D;
      g.ntn = 22; g.mtiles = ctx_later ? 136 : 128; g.conv = 1; g.C = G; g.ldc = DFF;
      g.cw = p.ffn_conv + (size_t)l * 3 * DFF; g.cwC = DFF;
    } else if (pos == 8) {
      g.A1 = G; g.A2 = G; g.lda1 = DFF; g.lda2 = DFF; g.ksplit = DFF; g.Bt = W + OFF_FFNDN + l * SZ_FFNDN; g.K = DFF;
      g.ntn = 4; g.mtiles = ctx_later ? 136 : 128; g.C = Y; g.ldc = D;
    } else if (pos == 10) {
      g.A1 = H; g.A2 = H; g.lda1 = D; g.lda2 = D; g.ksplit = D; g.Bt = W + OFF_ODIN + i * SZ_ODIN; g.K = D;
      g.ntn = 16; g.mtiles = ctx_later ? 136 : 128; g.conv = 1; g.C = G1; g.ldc = D;
      g.cw = p.od_conv + (size_t)i * 3 * D; g.cwC = D;
    }
    switch (type) {
      case T_PRE: pre_phase(p, smem); break;
      case T_ROW:
        if (pos == -1) row_phase(p, false, true, MT, nullptr, MOD, 0, p.norm_g, p.norm_g, MOD, 0, H, true);
        else if (pos == 6) row_phase(p, true, true, ctx_later ? MT : ML, Y, MODL, 2, gn + D, gn + 2 * D, MODL, 3, H, l == 0);
        else row_phase(p, true, l < DEPTH - 1, ctx_later ? MT : ML, Y, MODL, 5, gn + 3 * D, gn + (l < DEPTH - 1 ? 4 * D : 0),
                       MODL + (l < DEPTH - 1 ? 9 * 6144 : 0), 0, H, false);
        break;
      case T_PREP1: prep1_phase(p, i, ctx_in ? MT : ML, P, Rr, Kk, Vv, L, Dp); break;
      case T_LORA: gemm_phase<4, EPI_LORA>(g, smem); break;
      case T_GEMM_BF16: gemm8_bf16(g, smem); break;
      case T_SCAN:
        scan_phase(p, i, Rr, Kk, Vv, LO, LO + (size_t)MT * 512, LO + (size_t)2 * MT * 512, LO + (size_t)3 * MT * 512, Y0, Y1, smem);
        break;
      case T_MERGE:
        merge_phase(p, i, ctx_later ? MT : ML, Rr, Kk, Vv, LO + (size_t)2 * MT * 512, LO + (size_t)3 * MT * 512,
                    LO + (size_t)4 * MT * 512, Y0, Y1, YC);
        g.A1 = Dp; g.A2 = Dp; g.lda1 = 512; g.lda2 = 512; g.ksplit = 512; g.Bt = W + OFF_POOL + i * SZ_POOL; g.K = 512;
        g.ntn = 2; g.mtiles = ctx_later ? 136 : 128; g.C = YC + 512; g.ldc = 1024;
        gemm8_bf16(g, smem);
        break;
      case T_FFN: gemm8_ffn(g, smem); break;
      case T_ODD: gemm_phase<3, EPI_ODD>(g, smem); break;
    }
    if (coop && (ph + 1 < ph_hi || rep + 1 < reps)) {
      if (first_sync) { grid.sync(); first_sync = false; xb = xcd_barrier_post((unsigned*)(p.ws + B_BAR), xst); }
      else xcd_barrier(xb);
    }
    }
  }
}

extern "C" void kernel_launch(void* const* d_in, const int* in_sizes, int n_in, void* d_out, int out_size, void* d_ws,
                              size_t ws_size, hipStream_t stream) {
  Params p{};
  const float** pp = (const float**)&p;
  for (int k = 0; k < 28; ++k) pp[k] = (const float*)d_in[k];
  p.out = (float*)d_out;
  p.ws = (char*)d_ws;
  static int grid_blocks = 0;
  if (!grid_blocks) {
    int dev = 0, cus = 0, per_cu = 0;
    (void)hipGetDevice(&dev);
    (void)hipDeviceGetAttribute(&cus, hipDeviceAttributeMultiprocessorCount, dev);
    (void)hipOccupancyMaxActiveBlocksPerMultiprocessor(&per_cu, mega, NTHR, 0);
    if (per_cu > 1) per_cu = 1;
    if (per_cu < 1) per_cu = 1;
    grid_blocks = cus * per_cu;
    grid_blocks -= grid_blocks % 8;
  }
#if COOP
  int lo = 0, hi = NPHASES, coop = 1;
  void* args[] = {&p, &lo, &hi, &coop};
  hipError_t e = hipLaunchCooperativeKernel((void*)mega, dim3(grid_blocks), dim3(NTHR), args, 0, stream);
  if (e != hipSuccess) fprintf(stderr, "cooperative launch failed: %s (grid %d)\n", hipGetErrorString(e), grid_blocks);
#else
  for (int ph = 0; ph < NPHASES; ++ph) hipLaunchKernelGGL(mega, dim3(grid_blocks), dim3(NTHR), 0, stream, p, ph, ph + 1, 0);
#endif
}
```
